# Optimizing an MI355X kernel written in HIP

```python
import math
import jax, jax.numpy as jnp
from jax import lax
import numpy as np

D_MODEL = 2048
BATCH = 4
SEQ = 2048
DEPTH = 1

CHUNK = 64
Q_BLOCK = 128
D_MIX = D_MODEL
DIFF_WIDTH = D_MIX // 2
GLA_WIDTH = D_MIX - DIFF_WIDTH
DIFF_QK_DIM = 64
DIFF_V_DIM = 2 * DIFF_QK_DIM
DIFF_HEADS = DIFF_WIDTH // DIFF_V_DIM
ROT_DIM = DIFF_QK_DIM // 4
ROPE_THETA = 500000.0
GLA_HEADS = 4
GLA_V_DIM = GLA_WIDTH // GLA_HEADS
GLA_K_DIM = GLA_V_DIM // 2
GLA_GATE_RANK = 16
GLA_TAU = 16.0
N_GROUPS = 4
EXPERTS_PER_GROUP = 8
TOP_K = 2
D_FF_EXPERT = D_MODEL // 4
RMS_EPS = 1e-6

IN_SPLITS = (DIFF_HEADS * 2 * DIFF_QK_DIM,
             DIFF_HEADS * 2 * DIFF_QK_DIM,
             DIFF_HEADS * DIFF_V_DIM,
             GLA_HEADS * GLA_K_DIM,
             GLA_HEADS * GLA_K_DIM,
             GLA_HEADS * GLA_V_DIM,
             GLA_HEADS * GLA_V_DIM,
             GLA_GATE_RANK)
D_IN = sum(IN_SPLITS)

kernel_name = "hymba_diffattn_gla_hier_moe_block"


def rms_norm(x, g):
    xf = x.astype(jnp.float32)
    y = xf * lax.rsqrt(jnp.mean(xf * xf, axis=-1, keepdims=True) + RMS_EPS)
    return (y * g.astype(jnp.float32)).astype(x.dtype)


def partial_rope(t, cos, sin):
    half = ROT_DIM // 2
    x1 = t[..., :half].astype(jnp.float32)
    x2 = t[..., half:ROT_DIM].astype(jnp.float32)
    r = jnp.concatenate([x1 * cos - x2 * sin, x2 * cos + x1 * sin], axis=-1).astype(t.dtype)
    return jnp.concatenate([r, t[..., ROT_DIM:]], axis=-1)


def diff_attention(q, k, v, positions, q_g, k_g, lq1, lk1, lq2, lk2, out_g, lambda_init):
    B, S = q.shape[0], q.shape[1]
    q = rms_norm(q, q_g)
    k = rms_norm(k, k_g)
    inv = ROPE_THETA ** (-jnp.arange(0, ROT_DIM, 2, dtype=jnp.float32) / ROT_DIM)
    ang = positions.astype(jnp.float32)[..., None] * inv
    cos = jnp.cos(ang)[:, :, None, None, :]
    sin = jnp.sin(ang)[:, :, None, None, :]
    q = partial_rope(q, cos, sin)
    k = partial_rope(k, cos, sin)
    lam = (jnp.exp(jnp.sum(lq1.astype(jnp.float32) * lk1.astype(jnp.float32)))
           - jnp.exp(jnp.sum(lq2.astype(jnp.float32) * lk2.astype(jnp.float32)))
           + lambda_init)
    scale = DIFF_QK_DIM ** -0.5
    n_qb = S // Q_BLOCK
    qb = q.reshape(B, n_qb, Q_BLOCK, DIFF_HEADS, 2, DIFF_QK_DIM).transpose(1, 0, 3, 4, 2, 5)
    kt = k.transpose(0, 2, 3, 1, 4)
    vt = v.transpose(0, 2, 1, 3)
    key_chunk = jnp.arange(S) // CHUNK

    def block(args):
        qi, idx = args
        s = jnp.einsum('bhmqd,bhmkd->bhmqk', qi, kt, preferred_element_type=jnp.float32) * scale
        q_chunk = (idx * Q_BLOCK + jnp.arange(Q_BLOCK)) // CHUNK
        mask = key_chunk[None, :] <= q_chunk[:, None]
        s = jnp.where(mask, s, -jnp.inf)
        p = jax.nn.softmax(s, axis=-1)
        w = p[:, :, 0] - lam * p[:, :, 1]
        return jnp.einsum('bhqk,bhkd->bhqd', w.astype(vt.dtype), vt)

    o = lax.map(block, (qb, jnp.arange(n_qb)))
    o = o.transpose(1, 0, 3, 2, 4).reshape(B, S, DIFF_HEADS, DIFF_V_DIM)
    o = rms_norm(o, out_g) * (1.0 - lambda_init)
    return o.reshape(B, S, DIFF_HEADS * DIFF_V_DIM)


def gla(q, k, v, r, a, w_gate2, b_gate, out_g):
    B, S = q.shape[0], q.shape[1]
    n_c = S // CHUNK
    pre = (a @ w_gate2 + b_gate).astype(jnp.float32)
    log_alpha = (jax.nn.log_sigmoid(pre) / GLA_TAU).reshape(B, S, GLA_HEADS, GLA_K_DIM)

    def chunked(t):
        return t.reshape(B, n_c, CHUNK, GLA_HEADS, t.shape[-1]).transpose(0, 3, 1, 2, 4).astype(jnp.float32)

    bcum = jnp.cumsum(chunked(log_alpha), axis=3)
    b_last = bcum[:, :, :, -1:, :]
    qf = chunked(q) * (GLA_K_DIM ** -0.5)
    kf = chunked(k)
    vf = chunked(v)
    q_in = qf * jnp.exp(bcum)
    k_in = kf * jnp.exp(-bcum)
    k_dec = kf * jnp.exp(b_last - bcum)
    tril = jnp.tril(jnp.ones((CHUNK, CHUNK), dtype=bool))
    att = jnp.where(tril, jnp.einsum('bhcid,bhcjd->bhcij', q_in, k_in), 0.0)
    o_intra = jnp.einsum('bhcij,bhcje->bhcie', att, vf)
    u = jnp.einsum('bhcld,bhcle->bhcde', k_dec, vf)
    decay = jnp.exp(b_last[:, :, :, 0, :])

    def step(state, inp):
        u_c, d_c = inp
        return d_c[..., None] * state + u_c, state

    s0 = jnp.zeros((B, GLA_HEADS, GLA_K_DIM, GLA_V_DIM), jnp.float32)
    _, s_in = lax.scan(step, s0, (jnp.moveaxis(u, 2, 0), jnp.moveaxis(decay, 2, 0)))
    s_in = jnp.moveaxis(s_in, 0, 2)
    o_inter = jnp.einsum('bhcld,bhcde->bhcle', q_in, s_in)
    o = (o_intra + o_inter).transpose(0, 2, 3, 1, 4).reshape(B, S, GLA_HEADS, GLA_V_DIM)
    o = rms_norm(o, out_g).reshape(B, S, GLA_HEADS * GLA_V_DIM)
    return (o * jax.nn.silu(r.astype(jnp.float32))).astype(r.dtype)


def hier_moe(h, w_rg, b_rg, w_re, b_re, w_gate, w_up, w_down):
    B, S, D = h.shape
    t = h.reshape(B * S, D)
    lg = jnp.einsum('td,dg->tg', t, w_rg, preferred_element_type=jnp.float32) + b_rg.astype(jnp.float32)
    pg = jax.nn.softmax(lg, axis=-1)
    g_sel = jnp.argmax(pg, axis=-1)
    pg_sel = jnp.take_along_axis(pg, g_sel[:, None], axis=-1)[:, 0]
    le = jnp.einsum('td,gde->tge', t, w_re, preferred_element_type=jnp.float32) + b_re.astype(jnp.float32)
    le_sel = jnp.take_along_axis(le, g_sel[:, None, None], axis=1)[:, 0]
    pe = jax.nn.softmax(le_sel, axis=-1)
    top_v, top_i = lax.top_k(pe, TOP_K)
    top_v = top_v / jnp.sum(top_v, axis=-1, keepdims=True)
    ew = jnp.sum(jax.nn.one_hot(top_i, EXPERTS_PER_GROUP, dtype=jnp.float32) * top_v[..., None], axis=1)
    combine = (jax.nn.one_hot(g_sel, N_GROUPS, dtype=jnp.float32)[:, :, None]
               * ew[:, None, :] * pg_sel[:, None, None])
    out = jnp.zeros_like(t)
    for g in range(N_GROUPS):
        hg = jax.nn.silu(jnp.einsum('td,edf->tef', t, w_gate[g])) * jnp.einsum('td,edf->tef', t, w_up[g])
        hg = hg * combine[:, g, :, None].astype(hg.dtype)
        out = out + jnp.einsum('tef,efd->td', hg, w_down[g])
    return out.reshape(B, S, D)


def setup_inputs(seed: int = 0) -> dict:
    key = jax.random.key(seed)
    ks = jax.random.split(key, 24)
    nrm = lambda k, s: jax.random.normal(k, s, dtype=jnp.float32)
    gain = lambda k, s: 1.0 + 0.02 * nrm(k, s)
    E, G, F = EXPERTS_PER_GROUP, N_GROUPS, D_FF_EXPERT
    offsets = jax.random.randint(ks[1], (BATCH, 1), 0, 256) * CHUNK
    positions = (offsets + jnp.arange(SEQ)[None, :]).astype(jnp.int32)
    return {
        "x": nrm(ks[0], (BATCH, SEQ, D_MODEL)),
        "positions": positions,
        "norm1_g": gain(ks[2], (DEPTH, D_MODEL)),
        "w_in": nrm(ks[3], (DEPTH, D_MODEL, D_IN)) * D_MODEL ** -0.5,
        "q_norm_g": gain(ks[4], (DEPTH, DIFF_QK_DIM)),
        "k_norm_g": gain(ks[5], (DEPTH, DIFF_QK_DIM)),
        "lambda_q1": 0.1 * nrm(ks[6], (DEPTH, DIFF_QK_DIM)),
        "lambda_k1": 0.1 * nrm(ks[7], (DEPTH, DIFF_QK_DIM)),
        "lambda_q2": 0.1 * nrm(ks[8], (DEPTH, DIFF_QK_DIM)),
        "lambda_k2": 0.1 * nrm(ks[9], (DEPTH, DIFF_QK_DIM)),
        "diff_out_norm_g": gain(ks[10], (DEPTH, DIFF_V_DIM)),
        "gla_w_gate2": nrm(ks[11], (DEPTH, GLA_GATE_RANK, GLA_HEADS * GLA_K_DIM)) * GLA_GATE_RANK ** -0.5,
        "gla_b_gate": 0.1 * nrm(ks[12], (DEPTH, GLA_HEADS * GLA_K_DIM)),
        "gla_out_norm_g": gain(ks[13], (DEPTH, GLA_V_DIM)),
        "w_out": nrm(ks[14], (DEPTH, D_MIX, D_MODEL)) * D_MIX ** -0.5,
        "norm2_g": gain(ks[15], (DEPTH, D_MODEL)),
        "w_router_group": nrm(ks[16], (DEPTH, D_MODEL, G)) * D_MODEL ** -0.5,
        "b_router_group": 0.01 * nrm(ks[17], (DEPTH, G)),
        "w_router_expert": nrm(ks[18], (DEPTH, G, D_MODEL, E)) * D_MODEL ** -0.5,
        "b_router_expert": 0.01 * nrm(ks[19], (DEPTH, G, E)),
        "w_gate_expert": nrm(ks[20], (DEPTH, G, E, D_MODEL, F)) * D_MODEL ** -0.5,
        "w_up_expert": nrm(ks[21], (DEPTH, G, E, D_MODEL, F)) * D_MODEL ** -0.5,
        "w_down_expert": nrm(ks[22], (DEPTH, G, E, F, D_MODEL)) * F ** -0.5,
    }


def reference(x, positions, norm1_g, w_in, q_norm_g, k_norm_g, lambda_q1, lambda_k1,
              lambda_q2, lambda_k2, diff_out_norm_g, gla_w_gate2, gla_b_gate, gla_out_norm_g,
              w_out, norm2_g, w_router_group, b_router_group, w_router_expert, b_router_expert,
              w_gate_expert, w_up_expert, w_down_expert):
    B, S, _ = x.shape
    split_idx = [int(v) for v in np.cumsum(IN_SPLITS)[:-1]]
    for l in range(DEPTH):
        lambda_init = 0.8 - 0.6 * math.exp(-0.3 * l)
        h = rms_norm(x, norm1_g[l])
        proj = h @ w_in[l]
        dq, dk, dv, gq, gk, gv, gr, ga = jnp.split(proj, split_idx, axis=-1)
        a_out = diff_attention(
            dq.reshape(B, S, DIFF_HEADS, 2, DIFF_QK_DIM),
            dk.reshape(B, S, DIFF_HEADS, 2, DIFF_QK_DIM),
            dv.reshape(B, S, DIFF_HEADS, DIFF_V_DIM),
            positions, q_norm_g[l], k_norm_g[l], lambda_q1[l], lambda_k1[l],
            lambda_q2[l], lambda_k2[l], diff_out_norm_g[l], lambda_init)
        g_out = gla(
            gq.reshape(B, S, GLA_HEADS, GLA_K_DIM),
            gk.reshape(B, S, GLA_HEADS, GLA_K_DIM),
            gv.reshape(B, S, GLA_HEADS, GLA_V_DIM),
            gr, ga, gla_w_gate2[l], gla_b_gate[l], gla_out_norm_g[l])
        mixed = jnp.concatenate([a_out, g_out.astype(a_out.dtype)], axis=-1) @ w_out[l]
        x = x + mixed
        x = x + hier_moe(rms_norm(x, norm2_g[l]), w_router_group[l], b_router_group[l],
                         w_router_expert[l], b_router_expert[l], w_gate_expert[l],
                         w_up_expert[l], w_down_expert[l])
    return x
```

```cpp
#include <hip/hip_runtime.h>
#include <cstdio>
#include <cstdint>
#include <cmath>
namespace pg8 {
#define PG8_LAS __attribute__((address_space(3)))
typedef unsigned short bf16_t;
typedef short bf16x8 __attribute__((ext_vector_type(8)));
typedef float f32x4 __attribute__((ext_vector_type(4)));
typedef unsigned u32x4 __attribute__((ext_vector_type(4)));
constexpr int BM = 256, BK = 64, HALF = 128, HTB = HALF * BK * 2  , STAGE_BYTES = 8 * HTB, NXCD = 8, WGM = 8;

__host__ __device__ __forceinline__ int lds_byte(int r, int c) { const int st = (r >> 4) * 2 + (c >> 5), rr = r & 15, cc = c & 31, ob = rr * 64 + cc * 2; return st * 1024 + (ob ^ (((ob >> 9) & 1) << 5)); }
__host__ __device__ __forceinline__ void stage_rc(int b, int& R, int& C) { const int st = b / 1024, sb = b % 1024, swz = sb ^ (((sb >> 9) & 1) << 5); R = (st >> 1) * 16 + swz / 64; C = (st & 1) * 32 + (swz % 64) / 2; }
__host__ __device__ __forceinline__ int perm32(int rho) { const int n = rho >> 4, i = rho & 15; return 8 * (i >> 2) + 4 * n + (i & 3); }

struct Unit { int pm, pn; };
struct Gemm { const bf16_t* A; const bf16_t* Bt; int M, N, K; };

struct StaticOrder {
    int nM, nN, nwg, G, c;
    __host__ __device__ void init(int M, int N, int G_, int c_) { nM = M / BM; nN = N / BM; nwg = nM * nN; G = G_; c = c_; }
    __host__ __device__ bool next(int i, Unit& u) const {
        const long L = (long)i * G + c; if (L >= nwg) return false;
        int wgid = (int)L; { const int q = nwg / NXCD, r = nwg % NXCD, xcd = wgid % NXCD, off = wgid / NXCD; wgid = (xcd < r ? xcd * (q + 1) : r * (q + 1) + (xcd - r) * q) + off; }
        const int nig = WGM * nN, gid = wgid / nig, fm = gid * WGM, gsz = (nM - fm) < WGM ? (nM - fm) : WGM;
        u.pm = fm + ((wgid % nig) % gsz); u.pn = (wgid % nig) / gsz; return true;
    }
    __device__ __forceinline__ void a_ready(const Unit&) const {}
    __device__ __forceinline__ void done(const Unit&) const {}
};

__device__ __forceinline__ unsigned cvt_pk_bf16(float lo, float hi) { unsigned r; asm volatile("v_cvt_pk_bf16_f32 %0, %1, %2" : "=v"(r) : "v"(lo), "v"(hi)); return r; }
typedef float f32x2 __attribute__((ext_vector_type(2)));
template <class Epi, class Sched, bool ALIGN_EPI = false, bool SP2 = false>
__device__ __forceinline__ void gemm_phase(PG8_LAS unsigned char* lds, const Gemm g, const Sched& S, const Epi& E) {
    const int tid = threadIdx.x, wid = __builtin_amdgcn_readfirstlane(tid >> 6), lane = tid & 63, wr = wid >> 2, wc = wid & 3, fr = lane & 15, fq = lane >> 4;
    const int K = g.K, nt = K / BK;
    unsigned voffA[2], voffB[2];
#pragma unroll
    for (int i = 0; i < 2; ++i) { int R, C; stage_rc(tid * 16 + i * 8192, R, C); const int Rb = Epi::PERM ? ((R & ~31) + perm32(R & 31)) : R;
        voffA[i] = (unsigned)(R * K + C) * 2u; voffB[i] = (unsigned)(Rb * K + C) * 2u; }
    const size_t kstep = (size_t)(BK * 2);
    const size_t hstep = (size_t)HALF * K * 2;
    const size_t tstep = 2 * hstep;
    const unsigned ldsw = (unsigned)wid * 1024u;
    const int aoff = lds_byte(wr * 64 + fr, fq * 8), boff = lds_byte(wc * 32 + fr, fq * 8);
#define PG8_SA(b, h) (((b) * 2 + (h)) * HTB)
#define PG8_SB(b, h) ((4 + (b) * 2 + (h)) * HTB)
#define PG8_STAGE(bufoff, gbase, voff) do { _Pragma("unroll") for (int _i = 0; _i < 2; ++_i) \
        __builtin_amdgcn_global_load_lds((const unsigned*)((const char*)(gbase) + (voff)[_i]), (PG8_LAS unsigned*)(lds + (bufoff) + ldsw + _i * 8192), 16, 0, 0); } while (0)
#define PG8_LDA(dst, b, h) do { _Pragma("unroll") for (int m = 0; m < 4; ++m) _Pragma("unroll") for (int k = 0; k < 2; ++k) dst[m][k] = *(const PG8_LAS bf16x8*)(lds + PG8_SA(b, h) + aoff + m * 2048 + k * 1024); } while (0)
#define PG8_LDB(dst, b, h) do { _Pragma("unroll") for (int n = 0; n < 2; ++n) _Pragma("unroll") for (int k = 0; k < 2; ++k) dst[n][k] = *(const PG8_LAS bf16x8*)(lds + PG8_SB(b, h) + boff + n * 2048 + k * 1024); } while (0)
#define PG8_MMA(ai, bj, At, Bt) do { __builtin_amdgcn_s_setprio(1); _Pragma("unroll") for (int m = 0; m < 4; ++m) _Pragma("unroll") for (int n = 0; n < 2; ++n) _Pragma("unroll") for (int k = 0; k < 2; ++k) \
        acc[ai][bj][m][n] = __builtin_amdgcn_mfma_f32_16x16x32_bf16(Bt[n][k], At[m][k], acc[ai][bj][m][n], 0, 0, 0); __builtin_amdgcn_s_setprio(0); } while (0)
#define PG8_WAIT_V(n) asm volatile("s_waitcnt vmcnt(" #n ")" ::: "memory")
#define PG8_WAIT_L(n) asm volatile("s_waitcnt lgkmcnt(" #n ")" ::: "memory")
#define PG8_BAR __builtin_amdgcn_s_barrier()
#define PG8_SCHED __builtin_amdgcn_sched_barrier(0)
    Unit cur, nxt; int ui = 0;
    if (!S.next(0, cur)) return;
    f32x4 acc[2][2][4][2];
#pragma unroll
    for (int a = 0; a < 2; ++a)
#pragma unroll
        for (int b = 0; b < 2; ++b)
#pragma unroll
            for (int m = 0; m < 4; ++m)
#pragma unroll
                for (int n = 0; n < 2; ++n) acc[a][b][m][n] = (f32x4){0.f, 0.f, 0.f, 0.f};
    bf16x8 At[4][2], B0[2][2], B1[2][2];
    const char* cA = (const char*)g.A + (size_t)cur.pm * tstep; const char* cB = (const char*)g.Bt + (size_t)cur.pn * tstep;
    S.a_ready(cur);
    if constexpr (SP2) {
        PG8_STAGE(PG8_SB(0, 0), cB, voffB); PG8_STAGE(PG8_SB(0, 1), cB + hstep, voffB); PG8_STAGE(PG8_SA(0, 0), cA, voffA); PG8_STAGE(PG8_SA(0, 1), cA + hstep, voffA);
        if (wr == 1) PG8_BAR;
        PG8_WAIT_V(2); PG8_BAR;
        PG8_STAGE(PG8_SB(1, 0), cB + kstep, voffB); PG8_STAGE(PG8_SA(1, 0), cA + kstep, voffA); PG8_STAGE(PG8_SB(1, 1), cB + hstep + kstep, voffB);
        PG8_WAIT_V(6); PG8_BAR;
    } else {
        PG8_STAGE(PG8_SB(0, 0), cB, voffB); PG8_STAGE(PG8_SA(0, 0), cA, voffA); PG8_STAGE(PG8_SB(0, 1), cB + hstep, voffB); PG8_STAGE(PG8_SA(0, 1), cA + hstep, voffA);
        if (wr == 1) PG8_BAR;
        PG8_WAIT_V(4); PG8_BAR;
        PG8_STAGE(PG8_SB(1, 0), cB + kstep, voffB); PG8_STAGE(PG8_SA(1, 0), cA + kstep, voffA); PG8_STAGE(PG8_SB(1, 1), cB + hstep + kstep, voffB);
        PG8_WAIT_V(6); PG8_BAR;
    }
    for (;;) {
        const bool has_next = S.next(ui + 1, nxt);
        const char* nA = has_next ? (const char*)g.A + (size_t)nxt.pm * tstep : cA; const char* nB = has_next ? (const char*)g.Bt + (size_t)nxt.pn * tstep : cB;
        for (int t = 0; t < nt; t += 2) {
            const bool last = (t == nt - 2);
            const char* a1 = cA + (size_t)(t + 1) * kstep;
            const char* a2 = last ? nA : cA + (size_t)(t + 2) * kstep; const char* b2 = last ? nB : cB + (size_t)(t + 2) * kstep;
            const char* a3 = a2 + kstep; const char* b3 = b2 + kstep;
            if (last && has_next) S.a_ready(nxt);
            if constexpr (SP2) {
            PG8_LDB(B0, 0, 0); PG8_LDB(B1, 0, 1); PG8_SCHED; PG8_LDA(At, 0, 0); PG8_STAGE(PG8_SA(1, 1), a1 + hstep, voffA);
            PG8_WAIT_V(8); PG8_WAIT_L(0); PG8_BAR; PG8_MMA(0, 0, At, B0); PG8_MMA(0, 1, At, B1); PG8_BAR; PG8_SCHED;
            PG8_LDA(At, 0, 1); PG8_STAGE(PG8_SB(0, 0), b2, voffB); PG8_STAGE(PG8_SB(0, 1), b2 + hstep, voffB); PG8_STAGE(PG8_SA(0, 0), a2, voffA);
            PG8_WAIT_V(8); PG8_WAIT_L(0); PG8_BAR; PG8_MMA(1, 0, At, B0); PG8_MMA(1, 1, At, B1); PG8_BAR; PG8_SCHED;
            PG8_LDB(B0, 1, 0); PG8_LDB(B1, 1, 1); PG8_SCHED; PG8_LDA(At, 1, 0); PG8_STAGE(PG8_SA(0, 1), a2 + hstep, voffA);
            PG8_WAIT_V(8); PG8_WAIT_L(0); PG8_BAR; PG8_MMA(0, 0, At, B0); PG8_MMA(0, 1, At, B1); PG8_BAR; PG8_SCHED;
            PG8_LDA(At, 1, 1); PG8_STAGE(PG8_SB(1, 0), b3, voffB); PG8_STAGE(PG8_SB(1, 1), b3 + hstep, voffB); PG8_STAGE(PG8_SA(1, 0), a3, voffA);
            PG8_WAIT_V(8); PG8_WAIT_L(0); PG8_BAR; PG8_MMA(1, 0, At, B0); PG8_MMA(1, 1, At, B1); PG8_BAR; PG8_SCHED;
            } else {
            PG8_LDB(B0, 0, 0); PG8_SCHED; PG8_LDA(At, 0, 0); PG8_STAGE(PG8_SA(1, 1), a1 + hstep, voffA);
            PG8_WAIT_L(8); PG8_BAR; PG8_WAIT_L(0); PG8_MMA(0, 0, At, B0); PG8_BAR; PG8_SCHED;
            PG8_LDB(B1, 0, 1); PG8_STAGE(PG8_SB(0, 0), b2, voffB);
            PG8_BAR; PG8_WAIT_L(0); PG8_MMA(0, 1, At, B1); PG8_BAR;
            PG8_LDA(At, 0, 1); PG8_STAGE(PG8_SA(0, 0), a2, voffA);
            PG8_BAR; PG8_WAIT_L(0); PG8_MMA(1, 0, At, B0); PG8_BAR; PG8_SCHED;
            PG8_STAGE(PG8_SB(0, 1), b2 + hstep, voffB);
            PG8_WAIT_V(6); PG8_BAR; PG8_MMA(1, 1, At, B1); PG8_BAR;
            PG8_LDB(B0, 1, 0); PG8_SCHED; PG8_LDA(At, 1, 0); PG8_STAGE(PG8_SA(0, 1), a2 + hstep, voffA);
            PG8_WAIT_L(8); PG8_BAR; PG8_WAIT_L(0); PG8_MMA(0, 0, At, B0); PG8_BAR; PG8_SCHED;
            PG8_LDB(B1, 1, 1); PG8_STAGE(PG8_SB(1, 0), b3, voffB);
            PG8_BAR; PG8_WAIT_L(0); PG8_MMA(0, 1, At, B1); PG8_BAR;
            PG8_LDA(At, 1, 1); PG8_STAGE(PG8_SA(1, 0), a3, voffA);
            PG8_BAR; PG8_WAIT_L(0); PG8_MMA(1, 0, At, B0); PG8_BAR; PG8_SCHED;
            PG8_STAGE(PG8_SB(1, 1), b3 + hstep, voffB);
            PG8_WAIT_V(6); PG8_BAR; PG8_MMA(1, 1, At, B1); PG8_BAR;
            }
        }
        if constexpr (ALIGN_EPI) { if (wr == 0) PG8_BAR; }
        if constexpr (!Epi::AFTER_DRAIN) { E(acc, cur, wr, wc, fr, fq); S.done(cur); }
        if (!has_next) break;
#pragma unroll
        for (int a = 0; a < 2; ++a)
#pragma unroll
            for (int b = 0; b < 2; ++b)
#pragma unroll
                for (int m = 0; m < 4; ++m)
#pragma unroll
                    for (int n = 0; n < 2; ++n) acc[a][b][m][n] = (f32x4){0.f, 0.f, 0.f, 0.f};
        cur = nxt; cA = nA; cB = nB; ++ui;
        if constexpr (ALIGN_EPI) { if (wr == 1) PG8_BAR; }
    }
    PG8_WAIT_V(0);
    if constexpr (!ALIGN_EPI) { if (wr == 0) PG8_BAR; }
    PG8_BAR;
    if constexpr (Epi::AFTER_DRAIN) { E.fused(acc, cur, wr, wc, fr, fq, lds, wid, lane); S.done(cur); }
#undef PG8_SA
#undef PG8_SB
#undef PG8_STAGE
#undef PG8_LDA
#undef PG8_LDB
#undef PG8_MMA
#undef PG8_WAIT_V
#undef PG8_WAIT_L
#undef PG8_BAR
#undef PG8_SCHED
}
}
namespace pg8 {
template <class Epi, class Sched, bool ALIGN_EPI = false, bool SP2 = false>
__device__ __forceinline__ void gemm_phase_ga(PG8_LAS unsigned char* lds, const Gemm g, const int* rowidx, const Sched& S, const Epi& E) {
    const int tid = threadIdx.x, wid = __builtin_amdgcn_readfirstlane(tid >> 6), lane = tid & 63, wr = wid >> 2, wc = wid & 3, fr = lane & 15, fq = lane >> 4;
    const int K = g.K, nt = K / BK;
    unsigned voffB[2]; int Ra[2]; unsigned Ca2[2];
#pragma unroll
    for (int i = 0; i < 2; ++i) { int R, C; stage_rc(tid * 16 + i * 8192, R, C); const int Rb = Epi::PERM ? ((R & ~31) + perm32(R & 31)) : R;
        Ra[i] = R; Ca2[i] = (unsigned)C * 2u; voffB[i] = (unsigned)(Rb * K + C) * 2u; }
    const size_t kstep = (size_t)(BK * 2);
    const size_t hstep = (size_t)HALF * K * 2;
    const size_t tstep = 2 * hstep;
    const unsigned ldsw = (unsigned)wid * 1024u;
    const int aoff = lds_byte(wr * 64 + fr, fq * 8), boff = lds_byte(wc * 32 + fr, fq * 8);
#define PG8_SA(b, h) (((b) * 2 + (h)) * HTB)
#define PG8_SB(b, h) ((4 + (b) * 2 + (h)) * HTB)
#define PG8_STAGE(bufoff, gbase, voff) do { _Pragma("unroll") for (int _i = 0; _i < 2; ++_i) \
        __builtin_amdgcn_global_load_lds((const unsigned*)((const char*)(gbase) + (voff)[_i]), (PG8_LAS unsigned*)(lds + (bufoff) + ldsw + _i * 8192), 16, 0, 0); } while (0)
#define PG8_LDA(dst, b, h) do { _Pragma("unroll") for (int m = 0; m < 4; ++m) _Pragma("unroll") for (int k = 0; k < 2; ++k) dst[m][k] = *(const PG8_LAS bf16x8*)(lds + PG8_SA(b, h) + aoff + m * 2048 + k * 1024); } while (0)
#define PG8_LDB(dst, b, h) do { _Pragma("unroll") for (int n = 0; n < 2; ++n) _Pragma("unroll") for (int k = 0; k < 2; ++k) dst[n][k] = *(const PG8_LAS bf16x8*)(lds + PG8_SB(b, h) + boff + n * 2048 + k * 1024); } while (0)
#define PG8_MMA(ai, bj, At, Bt) do { __builtin_amdgcn_s_setprio(1); _Pragma("unroll") for (int m = 0; m < 4; ++m) _Pragma("unroll") for (int n = 0; n < 2; ++n) _Pragma("unroll") for (int k = 0; k < 2; ++k) \
        acc[ai][bj][m][n] = __builtin_amdgcn_mfma_f32_16x16x32_bf16(Bt[n][k], At[m][k], acc[ai][bj][m][n], 0, 0, 0); __builtin_amdgcn_s_setprio(0); } while (0)
#define PG8_WAIT_V(n) asm volatile("s_waitcnt vmcnt(" #n ")" ::: "memory")
#define PG8_WAIT_L(n) asm volatile("s_waitcnt lgkmcnt(" #n ")" ::: "memory")
#define PG8_BAR __builtin_amdgcn_s_barrier()
#define PG8_SCHED __builtin_amdgcn_sched_barrier(0)
    Unit cur, nxt; int ui = 0;
    if (!S.next(0, cur)) return;
    f32x4 acc[2][2][4][2];
#pragma unroll
    for (int a = 0; a < 2; ++a)
#pragma unroll
        for (int b = 0; b < 2; ++b)
#pragma unroll
            for (int m = 0; m < 4; ++m)
#pragma unroll
                for (int n = 0; n < 2; ++n) acc[a][b][m][n] = (f32x4){0.f, 0.f, 0.f, 0.f};
    bf16x8 At[4][2], B0[2][2], B1[2][2];
#define PG8_GAROWS(u, dst) do { _Pragma("unroll") for (int h_ = 0; h_ < 2; ++h_) _Pragma("unroll") for (int i_ = 0; i_ < 2; ++i_) dst[h_][i_] = (unsigned)rowidx[(u).pm * BM + h_ * HALF + Ra[i_]] * (unsigned)(K * 2) + Ca2[i_]; } while (0)
    unsigned vc[2][2], vn[2][2];
    PG8_GAROWS(cur, vc);
    const char* cA = (const char*)g.A; const char* cB = (const char*)g.Bt + (size_t)cur.pn * tstep;
    S.a_ready(cur);
    if constexpr (SP2) {
        PG8_STAGE(PG8_SB(0, 0), cB, voffB); PG8_STAGE(PG8_SB(0, 1), cB + hstep, voffB); PG8_STAGE(PG8_SA(0, 0), cA, vc[0]); PG8_STAGE(PG8_SA(0, 1), cA, vc[1]);
        if (wr == 1) PG8_BAR;
        PG8_WAIT_V(2); PG8_BAR;
        PG8_STAGE(PG8_SB(1, 0), cB + kstep, voffB); PG8_STAGE(PG8_SA(1, 0), cA + kstep, vc[0]); PG8_STAGE(PG8_SB(1, 1), cB + hstep + kstep, voffB);
        PG8_WAIT_V(6); PG8_BAR;
    } else {
        PG8_STAGE(PG8_SB(0, 0), cB, voffB); PG8_STAGE(PG8_SA(0, 0), cA, vc[0]); PG8_STAGE(PG8_SB(0, 1), cB + hstep, voffB); PG8_STAGE(PG8_SA(0, 1), cA, vc[1]);
        if (wr == 1) PG8_BAR;
        PG8_WAIT_V(4); PG8_BAR;
        PG8_STAGE(PG8_SB(1, 0), cB + kstep, voffB); PG8_STAGE(PG8_SA(1, 0), cA + kstep, vc[0]); PG8_STAGE(PG8_SB(1, 1), cB + hstep + kstep, voffB);
        PG8_WAIT_V(6); PG8_BAR;
    }
    for (;;) {
        const bool has_next = S.next(ui + 1, nxt);
        if (has_next) { PG8_GAROWS(nxt, vn); } else { _Pragma("unroll") for (int h_ = 0; h_ < 2; ++h_) _Pragma("unroll") for (int i_ = 0; i_ < 2; ++i_) vn[h_][i_] = vc[h_][i_]; }
        const char* nB = has_next ? (const char*)g.Bt + (size_t)nxt.pn * tstep : cB;
        for (int t = 0; t < nt; t += 2) {
            const bool last = (t == nt - 2);
            const char* a1 = cA + (size_t)(t + 1) * kstep;
            unsigned w0[2], w1[2];
            _Pragma("unroll") for (int i_ = 0; i_ < 2; ++i_) { w0[i_] = last ? vn[0][i_] : vc[0][i_]; w1[i_] = last ? vn[1][i_] : vc[1][i_]; }
            const char* a2 = last ? cA : cA + (size_t)(t + 2) * kstep; const char* b2 = last ? nB : cB + (size_t)(t + 2) * kstep;
            const char* a3 = a2 + kstep; const char* b3 = b2 + kstep;
            if (last && has_next) S.a_ready(nxt);
            if constexpr (SP2) {
            PG8_LDB(B0, 0, 0); PG8_LDB(B1, 0, 1); PG8_SCHED; PG8_LDA(At, 0, 0); PG8_STAGE(PG8_SA(1, 1), a1, vc[1]);
            PG8_WAIT_V(8); PG8_WAIT_L(0); PG8_BAR; PG8_MMA(0, 0, At, B0); PG8_MMA(0, 1, At, B1); PG8_BAR; PG8_SCHED;
            PG8_LDA(At, 0, 1); PG8_STAGE(PG8_SB(0, 0), b2, voffB); PG8_STAGE(PG8_SB(0, 1), b2 + hstep, voffB); PG8_STAGE(PG8_SA(0, 0), a2, w0);
            PG8_WAIT_V(8); PG8_WAIT_L(0); PG8_BAR; PG8_MMA(1, 0, At, B0); PG8_MMA(1, 1, At, B1); PG8_BAR; PG8_SCHED;
            PG8_LDB(B0, 1, 0); PG8_LDB(B1, 1, 1); PG8_SCHED; PG8_LDA(At, 1, 0); PG8_STAGE(PG8_SA(0, 1), a2, w1);
            PG8_WAIT_V(8); PG8_WAIT_L(0); PG8_BAR; PG8_MMA(0, 0, At, B0); PG8_MMA(0, 1, At, B1); PG8_BAR; PG8_SCHED;
            PG8_LDA(At, 1, 1); PG8_STAGE(PG8_SB(1, 0), b3, voffB); PG8_STAGE(PG8_SB(1, 1), b3 + hstep, voffB); PG8_STAGE(PG8_SA(1, 0), a3, w0);
            PG8_WAIT_V(8); PG8_WAIT_L(0); PG8_BAR; PG8_MMA(1, 0, At, B0); PG8_MMA(1, 1, At, B1); PG8_BAR; PG8_SCHED;
            } else {
            PG8_LDB(B0, 0, 0); PG8_SCHED; PG8_LDA(At, 0, 0); PG8_STAGE(PG8_SA(1, 1), a1, vc[1]);
            PG8_WAIT_L(8); PG8_BAR; PG8_WAIT_L(0); PG8_MMA(0, 0, At, B0); PG8_BAR; PG8_SCHED;
            PG8_LDB(B1, 0, 1); PG8_STAGE(PG8_SB(0, 0), b2, voffB);
            PG8_BAR; PG8_WAIT_L(0); PG8_MMA(0, 1, At, B1); PG8_BAR;
            PG8_LDA(At, 0, 1); PG8_STAGE(PG8_SA(0, 0), a2, w0);
            PG8_BAR; PG8_WAIT_L(0); PG8_MMA(1, 0, At, B0); PG8_BAR; PG8_SCHED;
            PG8_STAGE(PG8_SB(0, 1), b2 + hstep, voffB);
            PG8_WAIT_V(6); PG8_BAR; PG8_MMA(1, 1, At, B1); PG8_BAR;
            PG8_LDB(B0, 1, 0); PG8_SCHED; PG8_LDA(At, 1, 0); PG8_STAGE(PG8_SA(0, 1), a2, w1);
            PG8_WAIT_L(8); PG8_BAR; PG8_WAIT_L(0); PG8_MMA(0, 0, At, B0); PG8_BAR; PG8_SCHED;
            PG8_LDB(B1, 1, 1); PG8_STAGE(PG8_SB(1, 0), b3, voffB);
            PG8_BAR; PG8_WAIT_L(0); PG8_MMA(0, 1, At, B1); PG8_BAR;
            PG8_LDA(At, 1, 1); PG8_STAGE(PG8_SA(1, 0), a3, w0);
            PG8_BAR; PG8_WAIT_L(0); PG8_MMA(1, 0, At, B0); PG8_BAR; PG8_SCHED;
            PG8_STAGE(PG8_SB(1, 1), b3 + hstep, voffB);
            PG8_WAIT_V(6); PG8_BAR; PG8_MMA(1, 1, At, B1); PG8_BAR;
            }
        }
        if constexpr (ALIGN_EPI) { if (wr == 0) PG8_BAR; }
        if constexpr (!Epi::AFTER_DRAIN) { E(acc, cur, wr, wc, fr, fq); S.done(cur); }
        if (!has_next) break;
#pragma unroll
        for (int a = 0; a < 2; ++a)
#pragma unroll
            for (int b = 0; b < 2; ++b)
#pragma unroll
                for (int m = 0; m < 4; ++m)
#pragma unroll
                    for (int n = 0; n < 2; ++n) acc[a][b][m][n] = (f32x4){0.f, 0.f, 0.f, 0.f};
        cur = nxt; cB = nB; ++ui;
        _Pragma("unroll") for (int h_ = 0; h_ < 2; ++h_) _Pragma("unroll") for (int i_ = 0; i_ < 2; ++i_) vc[h_][i_] = vn[h_][i_];
        if constexpr (ALIGN_EPI) { if (wr == 1) PG8_BAR; }
    }
    PG8_WAIT_V(0);
    if constexpr (!ALIGN_EPI) { if (wr == 0) PG8_BAR; }
    PG8_BAR;
    if constexpr (Epi::AFTER_DRAIN) { E.fused(acc, cur, wr, wc, fr, fq, lds, wid, lane); S.done(cur); }
#undef PG8_SA
#undef PG8_SB
#undef PG8_STAGE
#undef PG8_LDA
#undef PG8_LDB
#undef PG8_MMA
#undef PG8_WAIT_V
#undef PG8_WAIT_L
#undef PG8_BAR
#undef PG8_SCHED
#undef PG8_GAROWS
}
}
#define MK_N_LAUNCHES 1
constexpr int NPHASE = 11;
constexpr int T = 8192, DM = 2048, SEQ = 2048;
constexpr int NPROJ = 6144, DIN = 6160;
constexpr int NEXP = 32, FFE = 512;
constexpr float EPS = 1e-6f;
constexpr float C2 = 0.125f * 1.4426950408889634f;
constexpr float QSCALE_GLA = 0.08838834764831845f;
constexpr float LAMBDA_INIT = 0.2f;
constexpr int NWAVES = 8;

constexpr size_t MiB = 1u << 20;
constexpr size_t WS_CTL = 0, CTL_ZERO_BYTES = 1 * MiB;
constexpr size_t WS_WIN_T = 1 * MiB;
constexpr size_t WS_WOUT_T = 25 * MiB;
constexpr size_t WS_WGU_T = 33 * MiB;
constexpr size_t WS_WD_T = 161 * MiB;
constexpr size_t WS_XN = 225 * MiB;
constexpr size_t WS_PROJ = 257 * MiB;
constexpr size_t WS_MIX = 353 * MiB;
constexpr size_t WS_H = 385 * MiB;
constexpr size_t WS_U = 409 * MiB;
constexpr size_t WS_ST = 473 * MiB;
constexpr size_t WS_GA = 505 * MiB;
constexpr size_t WS_CS = WS_GA + 512 * 1024;
constexpr size_t WS_DEC = WS_CS + 512 * 1024;
constexpr size_t WS_TOKE = WS_DEC + 256 * 1024;
constexpr size_t WS_TOKR = WS_TOKE + 64 * 1024;
constexpr size_t WS_TOKW = WS_TOKR + 64 * 1024;
constexpr size_t WS_TILE = WS_TOKW + 64 * 1024;
constexpr size_t WS_WR = WS_TILE + 64 * 1024;
constexpr size_t WS_WCNT = WS_WR + 320 * 1024;
constexpr size_t WS_TOKP = WS_WCNT + 64 * 1024;
constexpr size_t WS_TOKS = WS_TOKP + 64 * 1024;
constexpr size_t WS_RS = WS_TOKS + 64 * 1024;
constexpr size_t WS_ROWTOK = WS_RS + 128 * 1024;
constexpr int MAXROWS = 24576;
constexpr size_t WS_END = 508 * MiB;
constexpr int CW_CNT = 64;
constexpr int CW_BAR = 4096;

#define GAS __attribute__((address_space(1)))
#define LAS __attribute__((address_space(3)))
typedef unsigned short bf16;
typedef unsigned v4u __attribute__((ext_vector_type(4)));
typedef unsigned v2u __attribute__((ext_vector_type(2)));
typedef float f32x4 __attribute__((ext_vector_type(4)));
typedef float f32x16 __attribute__((ext_vector_type(16)));
typedef float f32x2 __attribute__((ext_vector_type(2)));
typedef short bf16x8 __attribute__((ext_vector_type(8)));
typedef short s16x4 __attribute__((ext_vector_type(4)));
typedef LAS unsigned char* ldsp;
#define LDS_WAIT() asm volatile("s_waitcnt lgkmcnt(0)" ::: "memory")
__device__ __forceinline__ unsigned f2bf(float f) { unsigned u = __builtin_bit_cast(unsigned, f); return (u + 0x7fffu + ((u >> 16) & 1u)) >> 16; }
__device__ __forceinline__ unsigned pk2(float lo, float hi) { return pg8::cvt_pk_bf16(lo, hi); }
__device__ __forceinline__ float bf2f(unsigned short b) { return __builtin_bit_cast(float, (unsigned)b << 16); }
__device__ __forceinline__ float bflo(unsigned u) { return __builtin_bit_cast(float, u << 16); }
__device__ __forceinline__ float bfhi(unsigned u) { return __builtin_bit_cast(float, u & 0xffff0000u); }
__device__ __forceinline__ int crow(int r, int hh) { return (r & 3) + 8 * (r >> 2) + 4 * hh; }
__device__ __forceinline__ s16x4 vtr(const LAS unsigned char* p) { return __builtin_bit_cast(s16x4, __builtin_amdgcn_ds_read_tr16_b64_v4i16((LAS s16x4*)p)); }
__device__ __forceinline__ bf16x8 cat8(s16x4 a, s16x4 b) { return (bf16x8){a[0], a[1], a[2], a[3], b[0], b[1], b[2], b[3]}; }
__device__ __forceinline__ bf16x8 pack8(const f32x16& p, int b0) {
    v4u w; w.x = pk2(p[b0], p[b0 + 1]); w.y = pk2(p[b0 + 2], p[b0 + 3]); w.z = pk2(p[b0 + 4], p[b0 + 5]); w.w = pk2(p[b0 + 6], p[b0 + 7]);
    return __builtin_bit_cast(bf16x8, w);
}
#define MFMA32(a, b, c) __builtin_amdgcn_mfma_f32_32x32x16_bf16((a), (b), (c), 0, 0, 0)

#define XB_TMO      128
#define XB_XCNT(j)  (256  + 64 * (j))
#define XB_XSUB(j)  (1280 + 64 * (j))
#define XB_XGEN(j)  (2304 + 64 * (j))
#define XB_TOP      3328
#define XB_TOPGEN   3392
#define XCD_BAR_WORDS 3456
#define XB_SPIN_CAP (1u << 18)

__device__ __forceinline__ unsigned xb_ld(unsigned* p)              { return __hip_atomic_load(p, __ATOMIC_RELAXED, __HIP_MEMORY_SCOPE_AGENT); }
__device__ __forceinline__ unsigned xb_add(unsigned* p, unsigned v) { return __hip_atomic_fetch_add(p, v, __ATOMIC_RELAXED, __HIP_MEMORY_SCOPE_AGENT); }
__device__ __forceinline__ unsigned xb_xcc_id() { return (unsigned)__builtin_amdgcn_s_getreg((3 << 11) | 20) & 0xFu; }
#define XB_SPIN(cond, bar) do { unsigned _sp = 0; while (cond) { __builtin_amdgcn_s_sleep(1); \
    if ((++_sp & 255u) == 0u) { if (xb_ld(&(bar)[XB_TMO])) break; if (_sp > XB_SPIN_CAP) { atomicAdd(&(bar)[XB_TMO], 1u); break; } } } } while (0)

struct XcdBarrier {
    unsigned* bar; unsigned x;
    volatile LAS unsigned* st;
};

__device__ __forceinline__ XcdBarrier xcd_barrier_post(unsigned* bar, volatile LAS unsigned* st) {
    XcdBarrier b; b.bar = bar; b.x = xb_xcc_id(); b.st = st;
    if (threadIdx.x == 0) (void)xb_add(&bar[XB_XCNT(b.x)], 1u);
    return b;
}
__device__ __forceinline__ void xcd_barrier_complete(unsigned* bar, unsigned x, unsigned& nloc, unsigned& nx) {
    const unsigned G = gridDim.x * gridDim.y * gridDim.z;
    unsigned sum, cnt, mine, sp = 0u;
    for (;;) {
        sum = 0u; cnt = 0u; mine = 0u;
#pragma unroll
        for (unsigned j = 0; j < 16; ++j) { const unsigned c = xb_ld(&bar[XB_XCNT(j)]); sum += c; cnt += (c > 0u) ? 1u : 0u; mine = (j == x) ? c : mine; }
        if (sum == G) break;
        __builtin_amdgcn_s_sleep(1);
        if ((++sp & 255u) == 0u) { if (xb_ld(&bar[XB_TMO])) break; if (sp > XB_SPIN_CAP) { atomicAdd(&bar[XB_TMO], 1u); break; } }
    }
    nloc = mine > 0u ? mine : 1u; nx = cnt > 0u ? cnt : 1u;
}

__device__ __forceinline__ void xcd_barrier(const XcdBarrier& b) {
    asm volatile("s_waitcnt vmcnt(0)" ::: "memory");
    __syncthreads();
    if (threadIdx.x == 0) {
        unsigned* bar = b.bar;
        __builtin_amdgcn_s_waitcnt(0);
        unsigned nloc = b.st[0], nx = b.st[1];
        if (nloc == 0u) { xcd_barrier_complete(bar, b.x, nloc, nx); b.st[0] = nloc; b.st[1] = nx; }
        const unsigned old = xb_add(&bar[XB_XSUB(b.x)], 1u);
        const unsigned gen = old / nloc;
        if (old + 1u == (gen + 1u) * nloc) {
            __builtin_amdgcn_fence(__ATOMIC_RELEASE, "agent");
            asm volatile("s_waitcnt vmcnt(0)" ::: "memory");
            const unsigned og = xb_add(&bar[XB_TOP], 1u);
            const unsigned tg = og / nx;
            if (og + 1u == (tg + 1u) * nx) xb_add(&bar[XB_TOPGEN], 1u);
            else XB_SPIN(xb_ld(&bar[XB_TOPGEN]) == tg, bar);
            __builtin_amdgcn_fence(__ATOMIC_ACQUIRE, "agent");
            xb_add(&bar[XB_XGEN(b.x)], 1u);
            asm volatile("s_waitcnt vmcnt(0)" ::: "memory");
        } else {
            XB_SPIN(xb_ld(&bar[XB_XGEN(b.x)]) == gen, bar);
            __builtin_amdgcn_fence(__ATOMIC_ACQUIRE, "agent");
            asm volatile("s_waitcnt vmcnt(0)" ::: "memory");
        }
    }
    __syncthreads();
}


struct Args { const float* in[23]; float* out; unsigned char* ws; float invf[8]; int ph_lo, ph_hi; };
struct Frame {
    ldsp lds; int tid, lane, wave, vcu, G;
};

__device__ __forceinline__ void tr_item64(const float* W, size_t pitch, int k0, int n0, bf16* WT, int Kdst, int drow0, int drow1, LAS float* scr, int lane) {
    const int kr = lane >> 4, nq = lane & 15;
    f32x4 v[16];
#pragma unroll
    for (int i = 0; i < 16; ++i) v[i] = *(const f32x4*)(W + (size_t)(k0 + 4 * i + kr) * pitch + n0 + 4 * nq);
#pragma unroll
    for (int i = 0; i < 16; ++i) { LAS float* d = scr + (4 * i + kr) * 65 + 4 * nq; d[0] = v[i].x; d[1] = v[i].y; d[2] = v[i].z; d[3] = v[i].w; }
    LDS_WAIT();
    const int c = lane & 7;
#pragma unroll
    for (int j = 0; j < 8; ++j) { const int n = (lane >> 3) + 8 * j; const LAS float* s = scr + (8 * c) * 65 + n;
        v4u o; o.x = pk2(s[0 * 65], s[1 * 65]); o.y = pk2(s[2 * 65], s[3 * 65]); o.z = pk2(s[4 * 65], s[5 * 65]); o.w = pk2(s[6 * 65], s[7 * 65]);
        const int drow = (n < 32) ? drow0 + n : drow1 + n - 32;
        *(v4u*)(WT + (size_t)drow * Kdst + k0 + 8 * c) = o; }
    LDS_WAIT();
}
__device__ __forceinline__ float wave_sum(float v) {
#pragma unroll
    for (int o = 1; o < 64; o <<= 1) v += __shfl_xor(v, o);
    return v;
}
__device__ __forceinline__ void p0_prologue(const Frame& F, const Args& A) {
    unsigned char* ws = A.ws;
    const int gw = F.vcu * NWAVES + F.wave, NGW = F.G * NWAVES;
    {
        const int* pos = (const int*)A.in[1]; float* cs = (float*)(ws + WS_CS);
        for (int t = blockIdx.x * 512 + F.tid; t < T; t += F.G * 512) {
            const double p = (double)pos[t];
#pragma unroll
            for (int i = 0; i < 8; ++i) {
                const double a = p * (double)A.invf[i] * 0.15915494309189535;
                const float fr = (float)(a - floor(a));
                cs[t * 16 + i] = __builtin_amdgcn_cosf(fr); cs[t * 16 + 8 + i] = __builtin_amdgcn_sinf(fr);
            }
        }
    }
    {
        const float* g2 = A.in[15]; const float* wrg = A.in[16]; const float* wre = A.in[18]; float* WR = (float*)(ws + WS_WR);
        for (int g = blockIdx.x * 512 + F.tid; g < 2048 * 36; g += F.G * 512) {
            const int j = g % 36, rq = g / 36, rho = rq & 511, q = rq >> 9;
            const int l = rho & 63, c = (rho >> 6) & 3, i = rho >> 8, kk = q * 512 + 4 * l + 256 * i + c;
            const float wv = (j < 4) ? wrg[kk * 4 + j] : wre[(size_t)((j - 4) >> 3) * (DM * 8) + kk * 8 + ((j - 4) & 7)];
            WR[g] = wv * g2[kk];
        }
    }
    {
        const float* x = A.in[0]; const float* g1 = A.in[2]; const float* win = A.in[3];
        bf16* XN = (bf16*)(ws + WS_XN); float* GA = (float*)(ws + WS_GA);
        LAS float* wl = (LAS float*)F.lds;
        for (int idx = F.tid; idx < 2048 * 16; idx += 512) {
            const int k = idx >> 4, r = idx & 15; const int lk = (k & 255) >> 2, i = k & 3, j = k >> 8;
            wl[((((j * 4 + i) * 4 + (r >> 2)) * 64 + lk) << 2) + (r & 3)] = win[(size_t)k * DIN + NPROJ + r];
        }
        __syncthreads();
        for (int rg = gw; rg < T / 2; rg += NGW) {
            float rstd[2];
            {
                f32x4 xv[2][8]; float ss[2];
#pragma unroll
                for (int rr = 0; rr < 2; ++rr) { ss[rr] = 0.f;
#pragma unroll
                    for (int j = 0; j < 8; ++j) { xv[rr][j] = *(const f32x4*)(x + (size_t)(rg * 2 + rr) * DM + 4 * F.lane + 256 * j); const f32x4 q = xv[rr][j] * xv[rr][j]; ss[rr] += (q.x + q.y) + (q.z + q.w); } }
#pragma unroll
                for (int rr = 0; rr < 2; ++rr) { ss[rr] = wave_sum(ss[rr]); rstd[rr] = 1.0f / sqrtf(ss[rr] * (1.0f / DM) + EPS);
#pragma unroll
                    for (int j = 0; j < 8; ++j) { const f32x4 g4 = *(const f32x4*)(g1 + 4 * F.lane + 256 * j); const f32x4 y = xv[rr][j] * rstd[rr] * g4;
                        v2u o; o.x = pk2(y.x, y.y); o.y = pk2(y.z, y.w);
                        *(v2u*)(XN + (size_t)(rg * 2 + rr) * DM + 4 * F.lane + 256 * j) = o; } }
            }
            f32x4 acc[2][4];
#pragma unroll
            for (int rr = 0; rr < 2; ++rr)
#pragma unroll
                for (int q = 0; q < 4; ++q) acc[rr][q] = (f32x4){0.f, 0.f, 0.f, 0.f};
#pragma unroll 1
            for (int j = 0; j < 8; ++j) {
                const f32x4 g4 = *(const f32x4*)(g1 + 4 * F.lane + 256 * j);
                f32x4 xj[2];
#pragma unroll
                for (int rr = 0; rr < 2; ++rr) xj[rr] = *(const f32x4*)(x + (size_t)(rg * 2 + rr) * DM + 4 * F.lane + 256 * j) * rstd[rr] * g4;
#pragma unroll
                for (int i = 0; i < 4; ++i)
#pragma unroll
                    for (int rq = 0; rq < 4; ++rq) { const f32x4 w4 = *(const LAS f32x4*)(wl + ((((j * 4 + i) * 4 + rq) * 64 + F.lane) << 2));
#pragma unroll
                        for (int rr = 0; rr < 2; ++rr) acc[rr][rq] += w4 * xj[rr][i]; }
            }
#pragma unroll
            for (int rr = 0; rr < 2; ++rr)
#pragma unroll
                for (int rq = 0; rq < 4; ++rq) { f32x4 a = acc[rr][rq]; a.x = wave_sum(a.x); a.y = wave_sum(a.y); a.z = wave_sum(a.z); a.w = wave_sum(a.w);
                    if (F.lane == 0) *(f32x4*)(GA + (size_t)(rg * 2 + rr) * 16 + rq * 4) = a; }
        }
        __syncthreads();
    }
    {
        LAS float* scr = (LAS float*)(F.lds + F.wave * 16640);
        const float* win = A.in[3]; const float* wout = A.in[14]; const float* wg = A.in[20]; const float* wu = A.in[21]; const float* wd = A.in[22];
        bf16* WinT = (bf16*)(ws + WS_WIN_T); bf16* WoutT = (bf16*)(ws + WS_WOUT_T); bf16* WguT = (bf16*)(ws + WS_WGU_T); bf16* WdT = (bf16*)(ws + WS_WD_T);
        constexpr int I_IN = 32 * 96, I_OUT = 32 * 32;
        for (int it = gw; it < I_IN + I_OUT; it += NGW) {
            int r = it;
            if (r < I_IN) { const int kb = r / 96, nb = r % 96; int d0 = nb * 64, d1 = nb * 64 + 32;
                if (nb < 32) { const int sec = nb >> 4, s = nb & 15; d0 = sec * 1024 + (s >> 2) * 256 + (s & 3) * 32; d1 = d0 + 128; }
                tr_item64(win, DIN, kb * 64, nb * 64, WinT, DM, d0, d1, scr, F.lane); continue; }
            r -= I_IN;
            if (r < I_OUT) { const int kb = r >> 5, nb = r & 31; tr_item64(wout, DM, kb * 64, nb * 64, WoutT, DM, nb * 64, nb * 64 + 32, scr, F.lane); continue; }
        }
    }
}

struct TrDesc { const float* src; size_t pitch; bf16* dst; int Kdst, d0, d1; };
__device__ __forceinline__ void tr_load(const TrDesc& d, f32x4 (&v)[16], int lane) {
    const int kr = lane >> 4, nq = lane & 15;
#pragma unroll
    for (int i = 0; i < 16; ++i) v[i] = *(const f32x4*)(d.src + (size_t)(4 * i + kr) * d.pitch + 4 * nq);
}
__device__ __forceinline__ void tr_stash(const f32x4 (&v)[16], LAS float* scr, int lane) {
    const int kr = lane >> 4, nq = lane & 15;
#pragma unroll
    for (int i = 0; i < 16; ++i) { LAS float* p = scr + (4 * i + kr) * 65 + 4 * nq; p[0] = v[i].x; p[1] = v[i].y; p[2] = v[i].z; p[3] = v[i].w; }
}
__device__ __forceinline__ void tr_flush(const TrDesc& d, LAS float* scr, int lane) {
    LDS_WAIT();
    const int c = lane & 7;
#pragma unroll
    for (int j = 0; j < 8; ++j) { const int n = (lane >> 3) + 8 * j; const LAS float* s = scr + (8 * c) * 65 + n;
        v4u o; o.x = pk2(s[0 * 65], s[1 * 65]); o.y = pk2(s[2 * 65], s[3 * 65]); o.z = pk2(s[4 * 65], s[5 * 65]); o.w = pk2(s[6 * 65], s[7 * 65]);
        const int drow = (n < 32) ? d.d0 + n : d.d1 + n - 32;
        *(v4u*)(d.dst + (size_t)drow * d.Kdst + 8 * c) = o; }
    LDS_WAIT();
}
constexpr int I_GATEUP = 2 * 32 * 32 * 8;
__device__ __forceinline__ TrDesc tr_desc_gateup(int r, const float* wg, const float* wu, bf16* WguT) {
    const int nb = r & 7, kb = (r >> 3) & 31, up = (r >> 8) & 1, e = r >> 9; const int n0 = nb * 64; const int d0 = e * 1024 + (n0 >> 7) * 256 + up * 128 + (n0 & 127);
    return TrDesc{(up ? wu : wg) + (size_t)e * DM * FFE + (size_t)(kb * 64) * FFE + n0, (size_t)FFE, WguT + kb * 64, DM, d0, d0 + 32};
}
constexpr int I_DOWN = 32 * 8 * 32;
__device__ __forceinline__ TrDesc tr_desc_down(int r, const float* wd, bf16* WdT) {
    const int nb = r & 31, kb = (r >> 5) & 7, e = r >> 8;
    return TrDesc{wd + (size_t)e * FFE * DM + (size_t)(kb * 64) * DM + nb * 64, (size_t)DM, WdT + kb * 64, FFE, e * 2048 + nb * 64, e * 2048 + nb * 64 + 32};
}
#define TR_STREAM(DESC_EXPR, it0, step, n, scr, lane) do { int ia_ = (it0), ib_ = (it0) + (step); f32x4 va_[16], vb_[16]; TrDesc da_, db_; \
        if (ia_ < (n)) { da_ = DESC_EXPR(ia_); tr_load(da_, va_, lane); } if (ib_ < (n)) { db_ = DESC_EXPR(ib_); tr_load(db_, vb_, lane); } \
        while (ia_ < (n)) { \
            { tr_stash(va_, scr, lane); const TrDesc dc_ = da_; ia_ += 2 * (step); if (ia_ < (n)) { da_ = DESC_EXPR(ia_); tr_load(da_, va_, lane); } tr_flush(dc_, scr, lane); } \
            if (ib_ < (n)) { tr_stash(vb_, scr, lane); const TrDesc dc_ = db_; ib_ += 2 * (step); if (ib_ < (n)) { db_ = DESC_EXPR(ib_); tr_load(db_, vb_, lane); } tr_flush(dc_, scr, lane); } \
        } } while (0)

struct EpiProj {
    static constexpr bool PERM = true, AFTER_DRAIN = false;
    bf16* proj; const float* cs; const float* qg; const float* kg;
    __device__ __forceinline__ void operator()(const pg8::f32x4 (&acc)[2][2][4][2], const pg8::Unit& u, int wr, int wc, int fr, int fq) const {
        const int row0 = u.pm * 256 + wr * 64 + fr;
        if (u.pn < 8) {
            const bool isq = u.pn < 4;
            const float* gp = isq ? qg : kg;
            bf16* base = proj + (isq ? (size_t)0 : (size_t)T * 1024) + ((u.pn & 3) * 4 + wc) * 64 + 8 * fq;
            f32x4 g[2][2];
#pragma unroll
            for (int bj = 0; bj < 2; ++bj)
#pragma unroll
                for (int n = 0; n < 2; ++n) g[bj][n] = *(const f32x4*)(gp + 32 * bj + 8 * fq + 4 * n);
            const float osc = isq ? C2 : 1.0f;
            const float sgn = (fq == 0) ? -1.0f : 1.0f;
#pragma unroll
            for (int ai = 0; ai < 2; ++ai)
#pragma unroll
                for (int m = 0; m < 4; ++m) {
                    const int row = row0 + ai * 128 + m * 16;
                    f32x4 v[2][2]; float ss = 0.f;
#pragma unroll
                    for (int bj = 0; bj < 2; ++bj)
#pragma unroll
                        for (int n = 0; n < 2; ++n) { v[bj][n] = acc[ai][bj][m][n]; const f32x4 q = v[bj][n] * v[bj][n]; ss += (q.x + q.y) + (q.z + q.w); }
                    ss += __shfl_xor(ss, 16); ss += __shfl_xor(ss, 32);
                    const float rstd = 1.0f / sqrtf(ss * (1.0f / 64.0f) + EPS);
#pragma unroll
                    for (int bj = 0; bj < 2; ++bj)
#pragma unroll
                        for (int n = 0; n < 2; ++n) v[bj][n] = v[bj][n] * rstd * g[bj][n];
                    f32x4 o0, o1;
                    o0.x = __shfl_xor(v[0][0].x, 16); o0.y = __shfl_xor(v[0][0].y, 16); o0.z = __shfl_xor(v[0][0].z, 16); o0.w = __shfl_xor(v[0][0].w, 16);
                    o1.x = __shfl_xor(v[0][1].x, 16); o1.y = __shfl_xor(v[0][1].y, 16); o1.z = __shfl_xor(v[0][1].z, 16); o1.w = __shfl_xor(v[0][1].w, 16);
                    if (fq < 2) {
                        const f32x4 c0 = *(const f32x4*)(cs + (size_t)row * 16), c1 = *(const f32x4*)(cs + (size_t)row * 16 + 4);
                        const f32x4 s0 = *(const f32x4*)(cs + (size_t)row * 16 + 8), s1 = *(const f32x4*)(cs + (size_t)row * 16 + 12);
                        v[0][0] = v[0][0] * c0 + o0 * s0 * sgn; v[0][1] = v[0][1] * c1 + o1 * s1 * sgn;
                    }
#pragma unroll
                    for (int bj = 0; bj < 2; ++bj) { const f32x4 a = v[bj][0] * osc, b = v[bj][1] * osc;
                        v4u w; w.x = pk2(a.x, a.y); w.y = pk2(a.z, a.w); w.z = pk2(b.x, b.y); w.w = pk2(b.z, b.w);
                        *(v4u*)(base + (size_t)row * 1024 + 32 * bj) = w; }
                }
        } else {
            int ld, ct; size_t off;
            if (u.pn < 12)      { off = (size_t)2 * T * 1024;            ld = 1024; ct = u.pn - 8; }
            else if (u.pn < 14) { off = (size_t)3 * T * 1024;            ld = 512;  ct = u.pn - 12; }
            else if (u.pn < 16) { off = (size_t)3 * T * 1024 + T * 512;  ld = 512;  ct = u.pn - 14; }
            else if (u.pn < 20) { off = (size_t)4 * T * 1024;            ld = 1024; ct = u.pn - 16; }
            else                { off = (size_t)5 * T * 1024;            ld = 1024; ct = u.pn - 20; }
            bf16* base = proj + off + ct * 256 + wc * 32 + 8 * fq;
#pragma unroll
            for (int ai = 0; ai < 2; ++ai)
#pragma unroll
                for (int m = 0; m < 4; ++m) { bf16* rowp = base + (size_t)(row0 + ai * 128 + m * 16) * ld;
#pragma unroll
                    for (int bj = 0; bj < 2; ++bj) { const f32x4 a = acc[ai][bj][m][0], b = acc[ai][bj][m][1];
                        v4u w; w.x = pk2(a.x, a.y); w.y = pk2(a.z, a.w); w.z = pk2(b.x, b.y); w.w = pk2(b.z, b.w);
                        *(v4u*)(rowp + bj * 128) = w; } }
        }
    }
};
struct EpiOut {
    static constexpr bool PERM = false, AFTER_DRAIN = false;
    const float* x; float* out;
    __device__ __forceinline__ void operator()(const pg8::f32x4 (&acc)[2][2][4][2], const pg8::Unit& u, int wr, int wc, int fr, int fq) const {
        const int row0 = u.pm * 256 + wr * 64 + fr, col0 = u.pn * 256 + wc * 32 + 4 * fq;
#pragma unroll
        for (int ai = 0; ai < 2; ++ai)
#pragma unroll
            for (int m = 0; m < 4; ++m) { const size_t ro = (size_t)(row0 + ai * 128 + m * 16) * DM + col0;
#pragma unroll
                for (int bj = 0; bj < 2; ++bj)
#pragma unroll
                    for (int n = 0; n < 2; ++n) { const size_t o = ro + bj * 128 + n * 16; *(f32x4*)(out + o) = *(const f32x4*)(x + o) + acc[ai][bj][m][n]; } }
    }
};
struct EpiG1 {
    static constexpr bool PERM = true, AFTER_DRAIN = false;
    bf16* H; const float* RS;
    __device__ __forceinline__ void operator()(const pg8::f32x4 (&acc)[2][2][4][2], const pg8::Unit& u, int wr, int wc, int fr, int fq) const {
        const int row0 = u.pm * 256 + wr * 64 + fr, col0 = (u.pn & 3) * 128 + wc * 32 + 8 * fq;
#pragma unroll
        for (int ai = 0; ai < 2; ++ai)
#pragma unroll
            for (int m = 0; m < 4; ++m) { float hv[8]; const float rs = RS[row0 + ai * 128 + m * 16];
#pragma unroll
                for (int n = 0; n < 2; ++n)
#pragma unroll
                    for (int j = 0; j < 4; ++j) { const float g = acc[ai][0][m][n][j] * rs, up = acc[ai][1][m][n][j] * rs; hv[n * 4 + j] = g / (1.0f + __expf(-g)) * up; }
                v4u w; w.x = pk2(hv[0], hv[1]); w.y = pk2(hv[2], hv[3]); w.z = pk2(hv[4], hv[5]); w.w = pk2(hv[6], hv[7]);
                *(v4u*)(H + (size_t)(row0 + ai * 128 + m * 16) * FFE + col0) = w; }
    }
};
struct EpiG2 {
    static constexpr bool PERM = true, AFTER_DRAIN = false;
    bf16* Y;
    __device__ __forceinline__ void operator()(const pg8::f32x4 (&acc)[2][2][4][2], const pg8::Unit& u, int wr, int wc, int fr, int fq) const {
        const int row0 = u.pm * 256 + wr * 64 + fr, col0 = (u.pn & 7) * 256 + wc * 32 + 8 * fq;
#pragma unroll
        for (int ai = 0; ai < 2; ++ai)
#pragma unroll
            for (int m = 0; m < 4; ++m) { bf16* rowp = Y + (size_t)(row0 + ai * 128 + m * 16) * DM + col0;
#pragma unroll
                for (int bj = 0; bj < 2; ++bj) { const f32x4 a = acc[ai][bj][m][0], b = acc[ai][bj][m][1];
                    v4u w; w.x = pk2(a.x, a.y); w.y = pk2(a.z, a.w); w.z = pk2(b.x, b.y); w.w = pk2(b.z, b.w);
                    *(v4u*)(rowp + bj * 128) = w; } }
    }
};
struct GroupedOrder {
    int nunits, nN, G, c; const int* tile_e;
    __device__ __forceinline__ bool next(int i, pg8::Unit& u) const {
        const int L = i * G + c; if (L >= nunits) return false;
        const int mt = L / nN, pl = L - mt * nN;
        u.pm = mt; u.pn = __builtin_amdgcn_readfirstlane(tile_e[mt]) * nN + pl; return true;
    }
    __device__ __forceinline__ void a_ready(const pg8::Unit&) const {}
    __device__ __forceinline__ void done(const pg8::Unit&) const {}
};

template <int R, int C, bool GATE>
__device__ __forceinline__ void row_norm_store(const LAS float* st, int pitch, const float* gain, float factor, bf16* dst, const bf16* gate) {
    constexpr int TPR = 512 / R, NK = C / (4 * TPR);
    const int tid = threadIdx.x, row = tid / TPR, part = tid % TPR;
    f32x4 v[NK]; float ss = 0.f;
#pragma unroll
    for (int k = 0; k < NK; ++k) { v[k] = *(const LAS f32x4*)(st + row * pitch + 4 * part + 4 * TPR * k); const f32x4 q = v[k] * v[k]; ss += (q.x + q.y) + (q.z + q.w); }
#pragma unroll
    for (int o = 1; o < TPR; o <<= 1) ss += __shfl_xor(ss, o);
    const float rstd = factor / sqrtf(ss * (1.0f / C) + EPS);
#pragma unroll
    for (int k = 0; k < NK; ++k) { const int col = 4 * part + 4 * TPR * k; const f32x4 g4 = *(const f32x4*)(gain + col); f32x4 o = v[k] * rstd * g4;
        if (GATE) { const v2u r2 = *(const v2u*)(gate + (size_t)row * 1024 + col); const float r0 = bflo(r2.x), r1 = bfhi(r2.x), r2f = bflo(r2.y), r3 = bfhi(r2.y);
            o.x *= r0 / (1.0f + __expf(-r0)); o.y *= r1 / (1.0f + __expf(-r1)); o.z *= r2f / (1.0f + __expf(-r2f)); o.w *= r3 / (1.0f + __expf(-r3)); }
        v2u w; w.x = pk2(o.x, o.y); w.y = pk2(o.z, o.w); *(v2u*)(dst + (size_t)row * DM + col) = w; }
}

constexpr int AT_KPITCH = 144, AT_VPITCH = 320, AT_V_OFF = 2 * 64 * 144, AT_BUF = AT_V_OFF + 64 * 320, AT_WS_OFF = 2 * AT_BUF, AT_ST_OFF = 0, AT_STP = 144;
__device__ __forceinline__ void attn_unit(const Frame& F, int b, int h, int qb, const bf16* Qp, const bf16* Kp, const bf16* Vp, bf16* MIX, float lam, float moff, const float* og) {
    const int tid = F.tid, lane = F.lane, w = F.wave, cl = lane & 31, hh = lane >> 5;
    const int map = w >> 2, rg = w & 3;
    const size_t tok0 = (size_t)b * SEQ; const int q0 = qb * 128;
    bf16x8 qf[4];
    { const bf16* qptr = Qp + (tok0 + q0 + rg * 32 + cl) * 1024 + (h * 2 + map) * 64 + 8 * hh;
#pragma unroll
      for (int ks = 0; ks < 4; ++ks) qf[ks] = *(const bf16x8*)(qptr + 16 * ks); }
    const int nt = 2 * qb + 2, mylast = 2 * qb + (rg >> 1);
    f32x16 o[4];
#pragma unroll
    for (int e = 0; e < 4; ++e)
#pragma unroll
        for (int r = 0; r < 16; ++r) o[e][r] = 0.f;
    float lsum = 0.f;
    const bf16* kg0 = Kp + (tok0 + (tid >> 3)) * 1024 + h * 128 + (tid & 7) * 8;
    const bf16* vg0 = Vp + (tok0 + (tid >> 4)) * 1024 + h * 128 + (tid & 15) * 8;
    const ldsp kdst = F.lds + (tid >> 3) * AT_KPITCH + (tid & 7) * 16;
    const ldsp vdst = F.lds + AT_V_OFF + (tid >> 4) * AT_VPITCH + (tid & 15) * 16;
    const ldsp kread = F.lds + map * (64 * AT_KPITCH) + cl * AT_KPITCH + 16 * hh;
    const ldsp vread = F.lds + AT_V_OFF + (4 * hh + ((lane & 15) >> 2)) * AT_VPITCH + (16 * ((lane >> 4) & 1) + 4 * (lane & 3)) * 2;
    v4u kr0 = *(const v4u*)kg0, kr1 = *(const v4u*)(kg0 + 64), vr0 = *(const v4u*)vg0, vr1 = *(const v4u*)(vg0 + 32 * 1024);
    *(LAS v4u*)kdst = kr0; *(LAS v4u*)(kdst + 64 * AT_KPITCH) = kr1; *(LAS v4u*)vdst = vr0; *(LAS v4u*)(vdst + 32 * AT_VPITCH) = vr1;
    { const size_t adv = (size_t)64 * 1024;
      kr0 = *(const v4u*)(kg0 + adv); kr1 = *(const v4u*)(kg0 + adv + 64); vr0 = *(const v4u*)(vg0 + adv); vr1 = *(const v4u*)(vg0 + adv + 32 * 1024); }
    __syncthreads();
    for (int t = 0; t < nt; ++t) {
        const int cb = (t & 1) * AT_BUF, nb = AT_BUF - cb;
        if (t + 1 < nt) {
            *(LAS v4u*)(kdst + nb) = kr0; *(LAS v4u*)(kdst + nb + 64 * AT_KPITCH) = kr1; *(LAS v4u*)(vdst + nb) = vr0; *(LAS v4u*)(vdst + nb + 32 * AT_VPITCH) = vr1;
            if (t + 2 < nt) { const size_t adv = (size_t)(t + 2) * 64 * 1024;
                kr0 = *(const v4u*)(kg0 + adv); kr1 = *(const v4u*)(kg0 + adv + 64); vr0 = *(const v4u*)(vg0 + adv); vr1 = *(const v4u*)(vg0 + adv + 32 * 1024); }
        }
        if (t <= mylast) {
            bf16x8 pa[4];
            {
                f32x16 s0, s1;
#pragma unroll
                for (int r = 0; r < 16; ++r) { s0[r] = -moff; s1[r] = -moff; }
                bf16x8 ka[2][4];
#pragma unroll
                for (int ks = 0; ks < 4; ++ks) { ka[0][ks] = *(const LAS bf16x8*)(kread + cb + ks * 32); ka[1][ks] = *(const LAS bf16x8*)(kread + cb + 32 * AT_KPITCH + ks * 32); }
#pragma unroll
                for (int ks = 0; ks < 4; ++ks) { s0 = MFMA32(ka[0][ks], qf[ks], s0); s1 = MFMA32(ka[1][ks], qf[ks], s1); }
#pragma unroll
                for (int r = 0; r < 16; ++r) { s0[r] = __builtin_amdgcn_exp2f(s0[r]); s1[r] = __builtin_amdgcn_exp2f(s1[r]); }
                float ls = 0.f;
#pragma unroll
                for (int r = 0; r < 16; ++r) ls += s0[r] + s1[r];
                lsum += ls;
                pa[0] = pack8(s0, 0); pa[1] = pack8(s0, 8); pa[2] = pack8(s1, 0); pa[3] = pack8(s1, 8);
            }
#pragma unroll
            for (int kst = 0; kst < 4; ++kst) {
                bf16x8 bv[4];
#pragma unroll
                for (int eb = 0; eb < 4; ++eb) { const ldsp p = vread + cb + kst * 16 * AT_VPITCH + eb * 64; bv[eb] = cat8(vtr(p), vtr(p + 8 * AT_VPITCH)); }
#pragma unroll
                for (int eb = 0; eb < 4; ++eb) o[eb] = MFMA32(pa[kst], bv[eb], o[eb]);
            }
        }
        __syncthreads();
    }
    lsum += __shfl_xor(lsum, 32);
    const float inv = (map == 0 ? 1.0f : lam) / lsum;
    LAS float* wsf = (LAS float*)(F.lds + AT_WS_OFF) + w * 32;
    if (hh == 0) wsf[cl] = inv;
    LDS_WAIT();
    float rinv[16];
#pragma unroll
    for (int r = 0; r < 16; ++r) rinv[r] = wsf[crow(r, hh)];
    LAS float* st = (LAS float*)(F.lds + AT_ST_OFF);
    if (map == 1) {
#pragma unroll
        for (int eb = 0; eb < 4; ++eb)
#pragma unroll
            for (int r = 0; r < 16; ++r) st[(rg * 32 + crow(r, hh)) * AT_STP + eb * 32 + cl] = o[eb][r] * rinv[r];
    }
    __syncthreads();
    if (map == 0) {
#pragma unroll
        for (int eb = 0; eb < 4; ++eb)
#pragma unroll
            for (int r = 0; r < 16; ++r) { const int ix = (rg * 32 + crow(r, hh)) * AT_STP + eb * 32 + cl; st[ix] = o[eb][r] * rinv[r] - st[ix]; }
    }
    __syncthreads();
    row_norm_store<128, 128, false>(st, AT_STP, og, 1.0f - LAMBDA_INIT, MIX + (tok0 + q0) * DM + h * 128, nullptr);
    __syncthreads();
}

constexpr int GL_GA = 0, GL_BC = 4096, GL_PART = GL_BC + 32768;
__device__ __forceinline__ void gla_bcum(const Frame& F, size_t tok0, int h, const float* GA, const float* W2, const float* B2) {
    const int tid = F.tid;
    LAS float* gas = (LAS float*)(F.lds + GL_GA); LAS float* bc = (LAS float*)(F.lds + GL_BC); LAS float* part = (LAS float*)(F.lds + GL_PART);
    if (tid < 256) *(LAS f32x4*)(gas + tid * 4) = *(const f32x4*)(GA + tok0 * 16 + tid * 4);
    const int d = tid & 127, qtr = tid >> 7;
    float w2[16];
#pragma unroll
    for (int r = 0; r < 16; ++r) w2[r] = W2[r * 512 + h * 128 + d];
    const float bb = B2[h * 128 + d];
    __syncthreads();
    float run = 0.f;
#pragma unroll
    for (int i = 0; i < 16; ++i) { const int l = qtr * 16 + i; float pre = bb;
#pragma unroll
        for (int r4 = 0; r4 < 4; ++r4) { const f32x4 g4 = *(const LAS f32x4*)(gas + l * 16 + r4 * 4); pre += g4.x * w2[r4 * 4] + g4.y * w2[r4 * 4 + 1] + g4.z * w2[r4 * 4 + 2] + g4.w * w2[r4 * 4 + 3]; }
        const float ls = fminf(pre, 0.f) - __logf(1.0f + __expf(-fabsf(pre)));
        run += ls * (1.0f / 16.0f); bc[l * 128 + d] = run; }
    part[qtr * 128 + d] = run;
    __syncthreads();
    float off = 0.f;
    if (qtr > 0) off += part[d];
    if (qtr > 1) off += part[128 + d];
    if (qtr > 2) off += part[256 + d];
#pragma unroll
    for (int i = 0; i < 16; ++i) bc[(qtr * 16 + i) * 128 + d] += off;
    __syncthreads();
}
constexpr int GA_KD = GL_PART + 2048, GA_KDP = 320, GA_V = GA_KD + 64 * GA_KDP, GA_VP = 576;
__device__ __forceinline__ void gla_a_unit(const Frame& F, int bh, int c, const bf16* GK, const bf16* GV, const float* GA, const float* W2, const float* B2, bf16* U, float* DEC) {
    const int tid = F.tid, lane = F.lane, w = F.wave, cl = lane & 31, hh = lane >> 5;
    const int b = bh >> 2, h = bh & 3; const size_t tok0 = (size_t)b * SEQ + c * 64;
    v4u kr[2], vr[4];
#pragma unroll
    for (int i = 0; i < 2; ++i) { const int p = tid + 512 * i, l = p >> 4, ch = p & 15; kr[i] = *(const v4u*)(GK + (tok0 + l) * 512 + h * 128 + ch * 8); }
#pragma unroll
    for (int i = 0; i < 4; ++i) { const int p = tid + 512 * i, l = p >> 5, ch = p & 31; vr[i] = *(const v4u*)(GV + (tok0 + l) * 1024 + h * 256 + ch * 8); }
    gla_bcum(F, tok0, h, GA, W2, B2);
    const LAS float* bc = (const LAS float*)(F.lds + GL_BC);
#pragma unroll
    for (int i = 0; i < 4; ++i) { const int p = tid + 512 * i, l = p >> 5, ch = p & 31; *(LAS v4u*)(F.lds + GA_V + l * GA_VP + ch * 16) = vr[i]; }
#pragma unroll
    for (int i = 0; i < 2; ++i) { const int p = tid + 512 * i, l = p >> 4, ch = p & 15;
        const f32x4 la = *(const LAS f32x4*)(bc + 63 * 128 + ch * 8), lb = *(const LAS f32x4*)(bc + 63 * 128 + ch * 8 + 4);
        const f32x4 ba = *(const LAS f32x4*)(bc + l * 128 + ch * 8), bb = *(const LAS f32x4*)(bc + l * 128 + ch * 8 + 4);
        const v4u k = kr[i]; v4u o;
        o.x = pk2(bflo(k.x) * __expf(la.x - ba.x), bfhi(k.x) * __expf(la.y - ba.y)); o.y = pk2(bflo(k.y) * __expf(la.z - ba.z), bfhi(k.y) * __expf(la.w - ba.w));
        o.z = pk2(bflo(k.z) * __expf(lb.x - bb.x), bfhi(k.z) * __expf(lb.y - bb.y)); o.w = pk2(bflo(k.w) * __expf(lb.z - bb.z), bfhi(k.w) * __expf(lb.w - bb.w));
        *(LAS v4u*)(F.lds + GA_KD + l * GA_KDP + ch * 16) = o; }
    if (tid < 128) DEC[(size_t)(bh * 32 + c) * 128 + tid] = __expf(bc[63 * 128 + tid]);
    __syncthreads();
    f32x16 acc[4];
#pragma unroll
    for (int nb = 0; nb < 4; ++nb)
#pragma unroll
        for (int r = 0; r < 16; ++r) acc[nb][r] = 0.f;
    const int trow = 4 * hh + ((lane & 15) >> 2), tcol = (16 * ((lane >> 4) & 1) + 4 * (lane & 3)) * 2;
    const ldsp vrd = F.lds + GA_V + trow * GA_VP + 64 * w + tcol;
    const ldsp krd = F.lds + GA_KD + trow * GA_KDP + tcol;
#pragma unroll
    for (int ks = 0; ks < 4; ++ks) { const bf16x8 a = cat8(vtr(vrd + ks * 16 * GA_VP), vtr(vrd + ks * 16 * GA_VP + 8 * GA_VP));
#pragma unroll
        for (int nb = 0; nb < 4; ++nb) { const bf16x8 bb = cat8(vtr(krd + ks * 16 * GA_KDP + nb * 64), vtr(krd + ks * 16 * GA_KDP + 8 * GA_KDP + nb * 64)); acc[nb] = MFMA32(a, bb, acc[nb]); } }
    bf16* up = U + ((size_t)(bh * 32 + c) * 256 + 32 * w) * 128 + cl;
#pragma unroll
    for (int nb = 0; nb < 4; ++nb)
#pragma unroll
        for (int r = 0; r < 16; ++r) up[(size_t)crow(r, hh) * 128 + 32 * nb] = (bf16)f2bf(acc[nb][r]);
    __syncthreads();
}
__device__ __forceinline__ void gla_scan(const Frame& F, const bf16* U, const float* DEC, bf16* ST) {
    for (int q = blockIdx.x * 512 + F.tid; q < 16 * 8192; q += F.G * 512) {
        const int bh = q >> 13, rem = q & 8191, d4 = (rem & 31) * 4;
        f32x4 s = (f32x4){0.f, 0.f, 0.f, 0.f};
        const size_t base = (size_t)bh * 32 * 32768 + (size_t)rem * 4;
#pragma unroll 4
        for (int c = 0; c < 32; ++c) {
            const v2u ub = *(const v2u*)(U + base + (size_t)c * 32768); const f32x4 u4 = (f32x4){bflo(ub.x), bfhi(ub.x), bflo(ub.y), bfhi(ub.y)}; const f32x4 dc = *(const f32x4*)(DEC + (size_t)(bh * 32 + c) * 128 + d4);
            v2u o; o.x = pk2(s.x, s.y); o.y = pk2(s.z, s.w); *(v2u*)(ST + base + (size_t)c * 32768) = o;
            s = s * dc + u4;
        }
    }
}
constexpr int GC_QI = GL_PART + 2048, GC_KI = GC_QI + 64 * 272, GC_V = GC_KI + 64 * 272, GC_VP = 576, GC_STP = 288;
__device__ __forceinline__ void gla_c_unit(const Frame& F, int bh, int c, const bf16* GQ, const bf16* GK, const bf16* GV, const bf16* GR, const float* GA, const float* W2, const float* B2, const bf16* ST, const float* og, bf16* MIX) {
    const int tid = F.tid, lane = F.lane, w = F.wave, cl = lane & 31, hh = lane >> 5;
    const int b = bh >> 2, h = bh & 3; const size_t tok0 = (size_t)b * SEQ + c * 64;
    const int ib = w & 1, eq = w >> 1;
    v4u qr[2], kr[2], vr[4]; bf16x8 bs[2][8];
#pragma unroll
    for (int i = 0; i < 2; ++i) { const int p = tid + 512 * i, l = p >> 4, ch = p & 15; qr[i] = *(const v4u*)(GQ + (tok0 + l) * 512 + h * 128 + ch * 8); kr[i] = *(const v4u*)(GK + (tok0 + l) * 512 + h * 128 + ch * 8); }
#pragma unroll
    for (int i = 0; i < 4; ++i) { const int p = tid + 512 * i, l = p >> 5, ch = p & 31; vr[i] = *(const v4u*)(GV + (tok0 + l) * 1024 + h * 256 + ch * 8); }
    { const bf16* stp = ST + ((size_t)(bh * 32 + c) * 256 + eq * 64 + cl) * 128 + 8 * hh;
#pragma unroll
      for (int e2 = 0; e2 < 2; ++e2)
#pragma unroll
          for (int ks = 0; ks < 8; ++ks) bs[e2][ks] = *(const bf16x8*)(stp + (size_t)e2 * 32 * 128 + 16 * ks); }
    gla_bcum(F, tok0, h, GA, W2, B2);
    const LAS float* bc = (const LAS float*)(F.lds + GL_BC);
    LAS bf16* qi = (LAS bf16*)(F.lds + GC_QI); LAS bf16* ki = (LAS bf16*)(F.lds + GC_KI);
#pragma unroll
    for (int i = 0; i < 2; ++i) { const int p = tid + 512 * i, l = p >> 4, ch = p & 15;
        const f32x4 ba = *(const LAS f32x4*)(bc + l * 128 + ch * 8), bb = *(const LAS f32x4*)(bc + l * 128 + ch * 8 + 4);
        const f32x4 ea = (f32x4){__expf(ba.x), __expf(ba.y), __expf(ba.z), __expf(ba.w)}, eb = (f32x4){__expf(bb.x), __expf(bb.y), __expf(bb.z), __expf(bb.w)};
        const v4u q = qr[i], k = kr[i]; v4u oq, ok;
        oq.x = pk2(bflo(q.x) * QSCALE_GLA * ea.x, bfhi(q.x) * QSCALE_GLA * ea.y); oq.y = pk2(bflo(q.y) * QSCALE_GLA * ea.z, bfhi(q.y) * QSCALE_GLA * ea.w);
        oq.z = pk2(bflo(q.z) * QSCALE_GLA * eb.x, bfhi(q.z) * QSCALE_GLA * eb.y); oq.w = pk2(bflo(q.w) * QSCALE_GLA * eb.z, bfhi(q.w) * QSCALE_GLA * eb.w);
        ok.x = pk2(bflo(k.x) / ea.x, bfhi(k.x) / ea.y); ok.y = pk2(bflo(k.y) / ea.z, bfhi(k.y) / ea.w);
        ok.z = pk2(bflo(k.z) / eb.x, bfhi(k.z) / eb.y); ok.w = pk2(bflo(k.w) / eb.z, bfhi(k.w) / eb.w);
        *(LAS v4u*)(qi + l * 136 + ch * 8) = oq; *(LAS v4u*)(ki + l * 136 + ch * 8) = ok; }
#pragma unroll
    for (int i = 0; i < 4; ++i) { const int p = tid + 512 * i, l = p >> 5, ch = p & 31; *(LAS v4u*)(F.lds + GC_V + l * GC_VP + ch * 16) = vr[i]; }
    __syncthreads();
    bf16x8 pa[4];
#pragma unroll
    for (int jb = 0; jb < 2; ++jb) {
        if (jb <= ib) {
            f32x16 s;
#pragma unroll
            for (int r = 0; r < 16; ++r) s[r] = 0.f;
#pragma unroll
            for (int ks = 0; ks < 8; ++ks) { const bf16x8 a = *(const LAS bf16x8*)(ki + (32 * jb + cl) * 136 + 16 * ks + 8 * hh); const bf16x8 bq = *(const LAS bf16x8*)(qi + (32 * ib + cl) * 136 + 16 * ks + 8 * hh); s = MFMA32(a, bq, s); }
#pragma unroll
            for (int r = 0; r < 16; ++r) { const int j = 32 * jb + crow(r, hh), i = 32 * ib + cl; if (j > i) s[r] = 0.f; }
            pa[jb * 2] = pack8(s, 0); pa[jb * 2 + 1] = pack8(s, 8);
        } else { pa[jb * 2] = (bf16x8){0, 0, 0, 0, 0, 0, 0, 0}; pa[jb * 2 + 1] = (bf16x8){0, 0, 0, 0, 0, 0, 0, 0}; }
    }
    f32x16 o[2];
#pragma unroll
    for (int e2 = 0; e2 < 2; ++e2)
#pragma unroll
        for (int r = 0; r < 16; ++r) o[e2][r] = 0.f;
    const ldsp vread = F.lds + GC_V + (4 * hh + ((lane & 15) >> 2)) * GC_VP + (16 * ((lane >> 4) & 1) + 4 * (lane & 3)) * 2;
#pragma unroll
    for (int e2 = 0; e2 < 2; ++e2)
#pragma unroll
        for (int kst = 0; kst < 4; ++kst) {
            if (kst < 2 * (ib + 1)) { const ldsp p = vread + kst * 16 * GC_VP + (eq * 2 + e2) * 64; const bf16x8 bv = cat8(vtr(p), vtr(p + 8 * GC_VP)); o[e2] = MFMA32(pa[kst], bv, o[e2]); }
        }
#pragma unroll
    for (int ks = 0; ks < 8; ++ks) { const bf16x8 a = *(const LAS bf16x8*)(qi + (32 * ib + cl) * 136 + 16 * ks + 8 * hh);
#pragma unroll
        for (int e2 = 0; e2 < 2; ++e2) o[e2] = MFMA32(a, bs[e2][ks], o[e2]); }
    __syncthreads();
    LAS float* st = (LAS float*)F.lds;
#pragma unroll
    for (int e2 = 0; e2 < 2; ++e2)
#pragma unroll
        for (int r = 0; r < 16; ++r) st[(32 * ib + crow(r, hh)) * GC_STP + eq * 64 + e2 * 32 + cl] = o[e2][r];
    __syncthreads();
    row_norm_store<64, 256, true>(st, GC_STP, og, 1.0f, MIX + tok0 * DM + 1024 + h * 256, GR + tok0 * 1024 + h * 256);
    __syncthreads();
}

__device__ __forceinline__ void router_phase(const Frame& F, const Args& A, const int dummy) {
    unsigned char* ws = A.ws;
    const float* x2 = A.out; const float* g2 = A.in[15]; const float* wrg = A.in[16]; const float* brg = A.in[17]; const float* wre = A.in[18]; const float* bre = A.in[19];
    bf16* XN = (bf16*)(ws + WS_XN); unsigned* wcnt = (unsigned*)(ws + WS_WCNT + (dummy ? 32768 : 0));
    LAS unsigned* lcnt = (LAS unsigned*)(F.lds + 81920 + 8 * 144 * 4);
    if (!dummy) { const int g = blockIdx.x * 512 + F.tid; if (g < MAXROWS) { ((int*)(ws + WS_ROWTOK))[g] = 0; ((float*)(ws + WS_RS))[g] = 0.f; } }
    if (F.tid < NEXP) lcnt[F.tid] = 0u;
    int* toke = (int*)(ws + WS_TOKE + (dummy ? WS_U - WS_TOKE : 0)); int* tokr = (int*)(ws + WS_TOKR + (dummy ? WS_U - WS_TOKE : 0)); float* tokw = (float*)(ws + WS_TOKW + (dummy ? WS_U - WS_TOKE : 0)); float* toks = (float*)(ws + WS_TOKS + (dummy ? WS_U - WS_TOKE : 0));
    LAS float* wq = (LAS float*)F.lds;
    const float* WR = (const float*)(ws + WS_WR);
    LAS float* lgs = (LAS float*)(F.lds + 81920);
    const int lane = F.lane;
    for (int base = 0; base < T / 4; base += F.G * NWAVES) {
        const int rg = base + blockIdx.x * NWAVES + F.wave; const bool act = rg < T / 4; const int rgc = act ? rg : 0;
        float myss = 0.f;
        f32x4 xnx[2][2];
#pragma unroll
        for (int i = 0; i < 2; ++i)
#pragma unroll
            for (int rr = 0; rr < 2; ++rr) xnx[rr][i] = *(const f32x4*)(x2 + (size_t)(rgc * 4 + rr) * DM + 4 * lane + 256 * i);
#pragma unroll 1
        for (int hf = 0; hf < 2; ++hf) {
            float ssq[2];
            f32x2 acc[2][18];
#pragma unroll
            for (int rr = 0; rr < 2; ++rr) { ssq[rr] = 0.f;
#pragma unroll
                for (int j = 0; j < 18; ++j) acc[rr][j] = (f32x2){0.f, 0.f}; }
#pragma unroll 1
            for (int q = 0; q < 4; ++q) {
                f32x4 xr[2][2];
#pragma unroll
                for (int i = 0; i < 2; ++i)
#pragma unroll
                    for (int rr = 0; rr < 2; ++rr) xr[rr][i] = xnx[rr][i];
                { const int sn = hf * 4 + q + 1, hfn = sn >> 2, qn = sn & 3;
                  if (sn < 8) {
#pragma unroll
                      for (int i = 0; i < 2; ++i)
#pragma unroll
                          for (int rr = 0; rr < 2; ++rr) xnx[rr][i] = *(const f32x4*)(x2 + (size_t)(rgc * 4 + hfn * 2 + rr) * DM + qn * 512 + 4 * lane + 256 * i); } }
#pragma unroll
                for (int i = 0; i < 2; ++i) { const f32x4 g4 = *(const f32x4*)(g2 + q * 512 + 4 * lane + 256 * i);
#pragma unroll
                    for (int rr = 0; rr < 2; ++rr) { const size_t o = (size_t)(rgc * 4 + hf * 2 + rr) * DM + q * 512 + 4 * lane + 256 * i;
                        const f32x4 sq = xr[rr][i] * xr[rr][i]; ssq[rr] += (sq.x + sq.y) + (sq.z + sq.w);
                        const f32x4 y = xr[rr][i] * g4; v2u w; w.x = pk2(y.x, y.y); w.y = pk2(y.z, y.w); if (act) *(v2u*)(XN + o) = w; } }
                __syncthreads();
                { const v4u* src = (const v4u*)(WR + (size_t)q * 512 * 36);
#pragma unroll
                  for (int u = 0; u < 9; ++u) ((LAS v4u*)wq)[F.tid + 512 * u] = src[F.tid + 512 * u]; }
                __syncthreads();
#pragma unroll
                for (int i = 0; i < 2; ++i) {
#pragma unroll
                    for (int c = 0; c < 4; ++c) {
                        const LAS float* wrow = wq + ((i * 4 + c) * 64 + lane) * 36;
                        f32x2 wv[18];
#pragma unroll
                        for (int jj = 0; jj < 9; ++jj) { const f32x4 t4 = *(const LAS f32x4*)(wrow + 4 * jj); wv[2 * jj] = (f32x2){t4.x, t4.y}; wv[2 * jj + 1] = (f32x2){t4.z, t4.w}; }
#pragma unroll
                        for (int rr = 0; rr < 2; ++rr) { const float xs = xr[rr][i][c]; const f32x2 x2v = (f32x2){xs, xs};
#pragma unroll
                            for (int j = 0; j < 18; ++j) acc[rr][j] = __builtin_elementwise_fma(x2v, wv[j], acc[rr][j]); }
                    }
                }
            }
            {
                float v[64];
#define RSTEP(M) { const bool up = (lane & (M)) != 0; _Pragma("unroll") for (int i = 0; i < (M); ++i) { const float send = up ? v[i] : v[i + (M)]; const float keep = up ? v[i + (M)] : v[i]; v[i] = keep + __shfl_xor(send, (M)); } }
#define ACCF(f) acc[(f) / 36][((f) % 36) >> 1][(f) & 1]
#pragma unroll
                for (int f = 0; f < 64; ++f) v[f] = ACCF(f);
                RSTEP(32) RSTEP(16) RSTEP(8) RSTEP(4) RSTEP(2) RSTEP(1)
                lgs[F.wave * 144 + hf * 72 + lane] = v[0];
#pragma unroll
                for (int f = 0; f < 8; ++f) v[f] = ACCF(64 + f);
                RSTEP(4) RSTEP(2) RSTEP(1)
                v[0] += __shfl_xor(v[0], 8); v[0] += __shfl_xor(v[0], 16); v[0] += __shfl_xor(v[0], 32);
                if (lane < 8) lgs[F.wave * 144 + hf * 72 + 64 + lane] = v[0];
#undef RSTEP
#undef ACCF
            }
#pragma unroll
            for (int rr = 0; rr < 2; ++rr) { ssq[rr] = wave_sum(ssq[rr]); if (lane == hf * 2 + rr) myss = ssq[rr]; }
        }
        LDS_WAIT();
        float my[36];
#pragma unroll
        for (int j = 0; j < 36; ++j) my[j] = lgs[F.wave * 144 + (lane & 3) * 36 + j];
        if (act && lane < 4) {
            const int t = rg * 4 + lane;
            const float rstd = 1.0f / sqrtf(myss * (1.0f / DM) + EPS);
            float lg[4]; int gs = 0; float mx = -INFINITY;
#pragma unroll
            for (int g = 0; g < 4; ++g) { lg[g] = my[g] * rstd + brg[g]; if (lg[g] > mx) { mx = lg[g]; gs = g; } }
            float sum = 0.f;
#pragma unroll
            for (int g = 0; g < 4; ++g) sum += __expf(lg[g] - mx);
            const float pgsel = 1.0f / sum;
            float le[8];
#pragma unroll
            for (int e = 0; e < 8; ++e) { const float v = (gs == 0) ? my[4 + e] : (gs == 1) ? my[12 + e] : (gs == 2) ? my[20 + e] : my[28 + e]; le[e] = v * rstd + bre[gs * 8 + e]; }
            int ia = 0; float ma = -INFINITY;
#pragma unroll
            for (int e = 0; e < 8; ++e) if (le[e] > ma) { ma = le[e]; ia = e; }
            int ib = 0; float mb = -INFINITY;
#pragma unroll
            for (int e = 0; e < 8; ++e) if (e != ia && le[e] > mb) { mb = le[e]; ib = e; }
            const float eb = __expf(mb - ma); const float wa = pgsel / (1.0f + eb), wb = pgsel * eb / (1.0f + eb);
            const int ea = gs * 8 + ia, ebx = gs * 8 + ib;
            const unsigned ra = __hip_atomic_fetch_add(lcnt + ea, 1u, __ATOMIC_RELAXED, __HIP_MEMORY_SCOPE_WORKGROUP);
            const unsigned rb = __hip_atomic_fetch_add(lcnt + ebx, 1u, __ATOMIC_RELAXED, __HIP_MEMORY_SCOPE_WORKGROUP);
            toke[t * 2] = ea; toke[t * 2 + 1] = ebx; tokr[t * 2] = (int)ra; tokr[t * 2 + 1] = (int)rb; tokw[t * 2] = wa; tokw[t * 2 + 1] = wb; toks[t] = rstd;
        }
    }
    __syncthreads();
    if (F.tid < NEXP) wcnt[blockIdx.x * NEXP + F.tid] = lcnt[F.tid];
}
__device__ __forceinline__ void moe_offsets(const Frame& F, LAS int* toff, LAS int* basel, const unsigned* wcnt) {
    LAS int* psum = (LAS int*)F.lds; LAS int* pcap = psum + 512; LAS int* cntl = pcap + 512;
    const int e = F.tid & 31, p = F.tid >> 5, b = blockIdx.x;
    int sacc = 0, cap = 0;
#pragma unroll
    for (int i = 0; i < 16; ++i) { const int row = p * 16 + i; const int v = (int)wcnt[row * NEXP + e]; if (row == b) cap = sacc; sacc += v; }
    psum[p * 32 + e] = sacc; pcap[p * 32 + e] = cap;
    __syncthreads();
    if (F.tid < NEXP) { int total = 0, base = 0;
        for (int q = 0; q < 16; ++q) { if (q == (b >> 4)) base = total + pcap[q * 32 + e]; total += psum[q * 32 + e]; }
        cntl[e] = total; basel[e] = base; }
    __syncthreads();
    if (F.tid == 0) { int a = 0;
        for (int q = 0; q < NEXP; ++q) { toff[q] = a; a += (cntl[q] + 255) >> 8; }
        toff[NEXP] = a; }
    __syncthreads();
}

constexpr int LDS_BYTES = 147456;
constexpr int RING_BYTES = 131072;
constexpr int MISC_OFF = LDS_BYTES - 4096;

__global__ void __launch_bounds__(NWAVES * 64, 2) fwd(Args args) {
    extern __shared__ __attribute__((aligned(16))) unsigned char lds_raw[];
    Frame F;
    F.lds = (ldsp)lds_raw;
    F.tid = threadIdx.x; F.lane = F.tid & 63; F.wave = __builtin_amdgcn_readfirstlane(F.tid >> 6);
    F.G = gridDim.x; { const int bx = blockIdx.x; F.vcu = (F.G % 8 == 0) ? (bx % 8) * (F.G / 8) + bx / 8 : bx; }
    volatile LAS unsigned* MISC = (volatile LAS unsigned*)(F.lds + MISC_OFF);
    LAS int* toff = (LAS int*)(F.lds + MISC_OFF + 512); LAS int* basel = toff + 64;
    LAS float* lamv = (LAS float*)(F.lds + MISC_OFF + 1024);
    unsigned char* ws = args.ws;
    unsigned* ctl = (unsigned*)(ws + WS_CTL);
    for (int u = F.tid; u < (LDS_BYTES - RING_BYTES) / 4; u += NWAVES * 64) ((LAS unsigned*)(F.lds + RING_BYTES))[u] = 0u;
    __syncthreads();
    const int lo = args.ph_lo, hi = args.ph_hi;
    XcdBarrier bar; bar.bar = ctl + CW_BAR; bar.x = 0; bar.st = nullptr;
    if (hi - lo > 1) bar = xcd_barrier_post(ctl + CW_BAR, MISC + 8);
#ifndef PH_MASK
#define PH_MASK 0x7ff
#endif
#define IN(k) (((PH_MASK >> (k)) & 1) && lo <= (k) && (k) < hi)
#ifndef REP_MASK
#define REP_MASK 0
#endif
#define REP(k) _Pragma("unroll 1") for (int rep_ = 0; rep_ <= ((REP_MASK >> (k)) & 1); ++rep_)
#ifdef PROBE_BAR
#define SEAM(k) do { if (IN(k) && IN((k) + 1)) { xcd_barrier(bar); xcd_barrier(bar); } } while (0)
#else
#define SEAM(k) do { if (IN(k) && IN((k) + 1)) xcd_barrier(bar); } while (0)
#endif

    bf16* WinT = (bf16*)(ws + WS_WIN_T); bf16* WoutT = (bf16*)(ws + WS_WOUT_T); bf16* WguT = (bf16*)(ws + WS_WGU_T); bf16* WdT = (bf16*)(ws + WS_WD_T);
    bf16* XN = (bf16*)(ws + WS_XN); bf16* PROJ = (bf16*)(ws + WS_PROJ); bf16* MIX = (bf16*)(ws + WS_MIX); bf16* HB = (bf16*)(ws + WS_H);
    bf16* YB = PROJ;
    bf16* U = (bf16*)(ws + WS_U); bf16* ST = (bf16*)(ws + WS_ST); float* GA = (float*)(ws + WS_GA); float* CS = (float*)(ws + WS_CS); float* DEC = (float*)(ws + WS_DEC);
    int* toke = (int*)(ws + WS_TOKE); int* tokr = (int*)(ws + WS_TOKR); float* tokw = (float*)(ws + WS_TOKW); int* tile = (int*)(ws + WS_TILE); int* tokp = (int*)(ws + WS_TOKP); float* toks = (float*)(ws + WS_TOKS); float* RS = (float*)(ws + WS_RS); int* rowtok = (int*)(ws + WS_ROWTOK);
    const bf16* Qp = PROJ; const bf16* Kp = PROJ + (size_t)T * 1024; const bf16* Vp = PROJ + (size_t)2 * T * 1024;
    const bf16* GQ = PROJ + (size_t)3 * T * 1024; const bf16* GK = GQ + (size_t)T * 512; const bf16* GV = PROJ + (size_t)4 * T * 1024; const bf16* GR = PROJ + (size_t)5 * T * 1024;

    if (IN(0)) { p0_prologue(F, args); }
    SEAM(0);
    if (IN(1)) {
        const bool split = (F.G == 256); const int GG = split ? 192 : F.G;
        if ((int)blockIdx.x < GG) {
            pg8::Gemm g{XN, WinT, T, NPROJ, DM}; pg8::StaticOrder S; S.init(T, NPROJ, GG, (int)blockIdx.x);
            EpiProj E{PROJ, CS, args.in[4], args.in[5]};
            pg8::gemm_phase<EpiProj, pg8::StaticOrder, true, true>(F.lds, g, S, E);
        }
        if (!split || (int)blockIdx.x >= GG) {
            LAS float* scr = (LAS float*)(F.lds + F.wave * 16640);
            const int cw = split ? ((int)blockIdx.x - GG) * NWAVES + F.wave : F.vcu * NWAVES + F.wave, ncw = split ? (F.G - GG) * NWAVES : F.G * NWAVES;
            if (!split) __syncthreads();
#define DESC_GU(i) tr_desc_gateup((i), args.in[20], args.in[21], WguT)
            TR_STREAM(DESC_GU, cw, ncw, I_GATEUP, scr, F.lane);
#ifdef PROBE_CONV2
            TR_STREAM(DESC_GU, cw, ncw, I_GATEUP, scr, F.lane);
#endif
#undef DESC_GU
        }
    }
    SEAM(1);
    if (IN(2)) {
        if (F.wave == 0) {
            const float a = wave_sum(args.in[6][F.lane] * args.in[7][F.lane]), b2 = wave_sum(args.in[8][F.lane] * args.in[9][F.lane]);
            float mq = fabsf(args.in[4][F.lane]), mk = fabsf(args.in[5][F.lane]);
#pragma unroll
            for (int o = 1; o < 64; o <<= 1) { mq = fmaxf(mq, __shfl_xor(mq, o)); mk = fmaxf(mk, __shfl_xor(mk, o)); }
            if (F.lane == 0) { lamv[0] = __expf(a) - __expf(b2) + LAMBDA_INIT; lamv[1] = 8.0f * mq * mk * 1.4426950408889634f; }
        }
        __syncthreads();
        const float lam = lamv[0], moff = lamv[1];
        for (int v = F.vcu; v < 256; v += F.G) {
            const int bh = v >> 3, s = v & 7;
#ifdef PROBE_ATT
#define ATT_PASSES 4
#else
#define ATT_PASSES 2
#endif
#pragma unroll 1
            for (int pass = 0; pass < ATT_PASSES; ++pass) attn_unit(F, bh >> 3, bh & 7, (pass & 1) ? 15 - s : s, Qp, Kp, Vp, MIX, lam, moff, args.in[10]);
        }
        for (int un = F.vcu; un < 512; un += F.G) gla_a_unit(F, un >> 5, un & 31, GK, GV, GA, args.in[11], args.in[12], U, DEC);
#ifdef PROBE_GLAA
        for (int un = F.vcu; un < 512; un += F.G) gla_a_unit(F, un >> 5, un & 31, GK, GV, GA, args.in[11], args.in[12], U, DEC);
#endif
    }
    SEAM(2);
    if (IN(3)) { gla_scan(F, U, DEC, ST); }
    SEAM(3);
    if (IN(4)) {
        for (int un = F.vcu; un < 512; un += F.G) gla_c_unit(F, un >> 5, un & 31, GQ, GK, GV, GR, GA, args.in[11], args.in[12], ST, args.in[13], MIX);
    }
    SEAM(4);
    if (IN(5)) {
        pg8::Gemm g{MIX, WoutT, T, DM, DM}; pg8::StaticOrder S; S.init(T, DM, F.G, (int)blockIdx.x);
        EpiOut E{args.in[0], args.out};
        pg8::gemm_phase<EpiOut, pg8::StaticOrder, false, true>(F.lds, g, S, E);
    }
    SEAM(5);
#ifdef PROBE_P6
    if (IN(6)) { router_phase(F, args, 1); __syncthreads(); }
#endif
    if (IN(6)) { router_phase(F, args, 0); }
    SEAM(6);
    if (IN(7)) {
        moe_offsets(F, toff, basel, (const unsigned*)(ws + WS_WCNT));
        if (blockIdx.x == 0 && F.tid < NEXP) { const int e = F.tid; for (int i = toff[e]; i < toff[e + 1]; ++i) tile[i] = e; if (e == 0) tile[100] = toff[NEXP]; }
#pragma unroll 1
        for (int i = 0; i < 8; ++i) {
            const int pi = blockIdx.x * 64 + F.wave * 8 + i, t = pi >> 1, e = toke[pi]; const int pos = toff[e] * 256 + basel[e] + tokr[pi];
            if (F.lane == 0) { tokp[pi] = pos; RS[pos] = toks[t]; rowtok[pos] = t; }
        }
    }
    SEAM(7);
    if (IN(8)) {
        const int ntile = __builtin_amdgcn_readfirstlane(tile[100]);
        pg8::Gemm g{XN, WguT, 0, 0, DM}; GroupedOrder S{ntile * 4, 4, F.G, (int)blockIdx.x, tile};
        EpiG1 E{HB, RS};
        pg8::gemm_phase_ga<EpiG1, GroupedOrder, true, true>(F.lds, g, rowtok, S, E);
        {
            const int nunits = ntile * 4, R = (nunits + F.G - 1) / F.G, c0 = nunits - F.G * (R - 1);
            int nl = F.G - c0; const int c = (int)blockIdx.x; int li = c - c0;
            if (nl <= 0) { nl = F.G; li = c; }
            int q = (I_DOWN + nl - 1) / nl; if (q > 96) q = 96;
            const int nA = (nl * q < I_DOWN) ? nl * q : I_DOWN;
            LAS float* scr = (LAS float*)(F.lds + F.wave * 16640);
#define DESC_DN(i) tr_desc_down((i), args.in[22], WdT)
            if (li >= 0) { const int lim = (li * q + q < nA) ? li * q + q : nA; TR_STREAM(DESC_DN, li * q + F.wave, NWAVES, lim, scr, F.lane); }
            TR_STREAM(DESC_DN, nA + F.vcu * NWAVES + F.wave, F.G * NWAVES, I_DOWN, scr, F.lane);
#undef DESC_DN
        }
    }
    SEAM(8);
    if (IN(9)) {
        const int ntile = __builtin_amdgcn_readfirstlane(tile[100]);
        pg8::Gemm g{HB, WdT, 0, 0, FFE}; GroupedOrder S{ntile * 8, 8, F.G, (int)blockIdx.x, tile};
        EpiG2 E{YB};
        pg8::gemm_phase<EpiG2, GroupedOrder, true, true>(F.lds, g, S, E);
    }
    SEAM(9);
#ifdef PROBE_P10
    if (IN(10)) {
        const int gw = F.vcu * NWAVES + F.wave, NGW = F.G * NWAVES;
        for (int t = gw; t < T; t += NGW) {
            const size_t pa = (size_t)tokp[2 * t], pb = (size_t)tokp[2 * t + 1];
            const float wa = tokw[2 * t], wb = tokw[2 * t + 1];
            const float* orow = args.out + (size_t)t * DM; float* drow = (float*)(ws + WS_U) + (size_t)t * DM; const bf16* ya = YB + pa * DM; const bf16* yb = YB + pb * DM;
#pragma unroll
            for (int j = 0; j < 8; ++j) { const int col = 4 * F.lane + 256 * j; f32x4 v = *(const f32x4*)(orow + col);
                const v2u a = *(const v2u*)(ya + col), b = *(const v2u*)(yb + col);
                v.x += wa * bflo(a.x) + wb * bflo(b.x); v.y += wa * bfhi(a.x) + wb * bfhi(b.x); v.z += wa * bflo(a.y) + wb * bflo(b.y); v.w += wa * bfhi(a.y) + wb * bfhi(b.y);
                *(f32x4*)(drow + col) = v; }
        }
    }
    __syncthreads();
#endif
    if (IN(10)) {
        const int gw = F.vcu * NWAVES + F.wave, NGW = F.G * NWAVES;
        for (int t0 = gw; t0 < T; t0 += 4 * NGW) {
            int pa[4], pb[4]; float wa[4], wb[4];
#pragma unroll
            for (int k = 0; k < 4; ++k) { const int t = t0 + k * NGW; const bool ok = t < T; const int tc = ok ? t : 0; pa[k] = tokp[2 * tc]; pb[k] = tokp[2 * tc + 1]; wa[k] = tokw[2 * tc]; wb[k] = tokw[2 * tc + 1]; }
#pragma unroll
            for (int k = 0; k < 4; ++k) { const int t = t0 + k * NGW; if (t < T) {
                float* orow = args.out + (size_t)t * DM; const bf16* ya = YB + (size_t)pa[k] * DM; const bf16* yb = YB + (size_t)pb[k] * DM;
                f32x4 v[8]; v2u a[8], b[8];
#pragma unroll
                for (int j = 0; j < 8; ++j) { const int col = 4 * F.lane + 256 * j; v[j] = *(const f32x4*)(orow + col); a[j] = *(const v2u*)(ya + col); b[j] = *(const v2u*)(yb + col); }
#pragma unroll
                for (int j = 0; j < 8; ++j) { const int col = 4 * F.lane + 256 * j; f32x4 o = v[j];
                    o.x += wa[k] * bflo(a[j].x) + wb[k] * bflo(b[j].x); o.y += wa[k] * bfhi(a[j].x) + wb[k] * bfhi(b[j].x); o.z += wa[k] * bflo(a[j].y) + wb[k] * bflo(b[j].y); o.w += wa[k] * bfhi(a[j].y) + wb[k] * bfhi(b[j].y);
                    *(f32x4*)(orow + col) = o; } } }
        }
    }
#undef IN
#undef SEAM
}

extern "C" void kernel_launch(void* const* d_in, const int* in_sizes, int n_in, void* d_out, int out_size, void* d_ws, size_t ws_size, hipStream_t stream) {
    static int grid = 0;
    if (grid == 0) {
        if (n_in != 23 || in_sizes[0] != T * DM || out_size != T * DM || ws_size < WS_END) { fprintf(stderr, "kernel_launch: unexpected shapes (n_in %d, in0 %d, out %d, ws %zu)\n", n_in, n_in > 0 ? in_sizes[0] : -1, out_size, ws_size); grid = -1; return; }
        int dev = 0, cus = 0, per_cu = 0;
        if (hipGetDevice(&dev) != hipSuccess || hipDeviceGetAttribute(&cus, hipDeviceAttributeMultiprocessorCount, dev) != hipSuccess) { grid = -1; return; }
        if (hipFuncSetAttribute((const void*)fwd, hipFuncAttributeMaxDynamicSharedMemorySize, LDS_BYTES) != hipSuccess) { fprintf(stderr, "kernel_launch: hipFuncSetAttribute failed\n"); grid = -1; return; }
        if (hipOccupancyMaxActiveBlocksPerMultiprocessor(&per_cu, (const void*)fwd, NWAVES * 64, LDS_BYTES) != hipSuccess || per_cu < 1) fprintf(stderr, "kernel_launch: occupancy query reports %d\n", per_cu);
        (void)hipGetLastError();
        grid = cus < 256 ? cus : 256;
    }
    if (grid < 0) return;
    if (hipMemsetAsync((char*)d_ws + WS_CTL, 0, CTL_ZERO_BYTES, stream) != hipSuccess) return;
    Args a{};
    for (int i = 0; i < 23; ++i) a.in[i] = (const float*)d_in[i];
    a.out = (float*)d_out; a.ws = (unsigned char*)d_ws;
    for (int i = 0; i < 8; ++i) a.invf[i] = (float)pow(500000.0, -(double)(2 * i) / 16.0);
    constexpr int NL = MK_N_LAUNCHES;
    for (int li = 0; li < NL; ++li) {
        a.ph_lo = (NL == 1) ? 0 : li; a.ph_hi = (NL == 1) ? NPHASE : li + 1;
        hipLaunchKernelGGL(fwd, dim3(grid), dim3(NWAVES * 64), LDS_BYTES, stream, a);
        if (hipPeekAtLastError() != hipSuccess) { fprintf(stderr, "kernel_launch: launch %d failed\n", li); break; }
    }
}
```

```cpp
#include <hip/hip_runtime.h>
#include <cstdio>
#include <cstdint>
#include <cmath>
namespace pg8 {
#define PG8_LAS __attribute__((address_space(3)))
typedef unsigned short bf16_t;
typedef short bf16x8 __attribute__((ext_vector_type(8)));
typedef float f32x4 __attribute__((ext_vector_type(4)));
typedef unsigned u32x4 __attribute__((ext_vector_type(4)));
constexpr int BM = 256, BK = 64, HALF = 128, HTB = HALF * BK * 2  , STAGE_BYTES = 8 * HTB, NXCD = 8, WGM = 8;

__host__ __device__ __forceinline__ int lds_byte(int r, int c) { const int st = (r >> 4) * 2 + (c >> 5), rr = r & 15, cc = c & 31, ob = rr * 64 + cc * 2; return st * 1024 + (ob ^ (((ob >> 9) & 1) << 5)); }
__host__ __device__ __forceinline__ void stage_rc(int b, int& R, int& C) { const int st = b / 1024, sb = b % 1024, swz = sb ^ (((sb >> 9) & 1) << 5); R = (st >> 1) * 16 + swz / 64; C = (st & 1) * 32 + (swz % 64) / 2; }
__host__ __device__ __forceinline__ int perm32(int rho) { const int n = rho >> 4, i = rho & 15; return 8 * (i >> 2) + 4 * n + (i & 3); }

struct Unit { int pm, pn; };
struct Gemm { const bf16_t* A; const bf16_t* Bt; int M, N, K; };

struct StaticOrder {
    int nM, nN, nwg, G, c;
    __host__ __device__ void init(int M, int N, int G_, int c_) { nM = M / BM; nN = N / BM; nwg = nM * nN; G = G_; c = c_; }
    __host__ __device__ bool next(int i, Unit& u) const {
        const long L = (long)i * G + c; if (L >= nwg) return false;
        int wgid = (int)L; { const int q = nwg / NXCD, r = nwg % NXCD, xcd = wgid % NXCD, off = wgid / NXCD; wgid = (xcd < r ? xcd * (q + 1) : r * (q + 1) + (xcd - r) * q) + off; }
        const int nig = WGM * nN, gid = wgid / nig, fm = gid * WGM, gsz = (nM - fm) < WGM ? (nM - fm) : WGM;
        u.pm = fm + ((wgid % nig) % gsz); u.pn = (wgid % nig) / gsz; return true;
    }
    __device__ __forceinline__ void a_ready(const Unit&) const {}
    __device__ __forceinline__ void done(const Unit&) const {}
};

__device__ __forceinline__ unsigned cvt_pk_bf16(float lo, float hi) { unsigned r; asm volatile("v_cvt_pk_bf16_f32 %0, %1, %2" : "=v"(r) : "v"(lo), "v"(hi)); return r; }
typedef float f32x2 __attribute__((ext_vector_type(2)));
template <class Epi, class Sched, bool ALIGN_EPI = false, bool SP2 = false>
__device__ __forceinline__ void gemm_phase(PG8_LAS unsigned char* lds, const Gemm g, const Sched& S, const Epi& E) {
    const int tid = threadIdx.x, wid = __builtin_amdgcn_readfirstlane(tid >> 6), lane = tid & 63, wr = wid >> 2, wc = wid & 3, fr = lane & 15, fq = lane >> 4;
    const int K = g.K, nt = K / BK;
    unsigned voffA[2], voffB[2];
#pragma unroll
    for (int i = 0; i < 2; ++i) { int R, C; stage_rc(tid * 16 + i * 8192, R, C); const int Rb = Epi::PERM ? ((R & ~31) + perm32(R & 31)) : R;
        voffA[i] = (unsigned)(R * K + C) * 2u; voffB[i] = (unsigned)(Rb * K + C) * 2u; }
    const size_t kstep = (size_t)(BK * 2);
    const size_t hstep = (size_t)HALF * K * 2;
    const size_t tstep = 2 * hstep;
    const unsigned ldsw = (unsigned)wid * 1024u;
    const int aoff = lds_byte(wr * 64 + fr, fq * 8), boff = lds_byte(wc * 32 + fr, fq * 8);
#define PG8_SA(b, h) (((b) * 2 + (h)) * HTB)
#define PG8_SB(b, h) ((4 + (b) * 2 + (h)) * HTB)
#define PG8_STAGE(bufoff, gbase, voff) do { _Pragma("unroll") for (int _i = 0; _i < 2; ++_i) \
        __builtin_amdgcn_global_load_lds((const unsigned*)((const char*)(gbase) + (voff)[_i]), (PG8_LAS unsigned*)(lds + (bufoff) + ldsw + _i * 8192), 16, 0, 0); } while (0)
#define PG8_LDA(dst, b, h) do { _Pragma("unroll") for (int m = 0; m < 4; ++m) _Pragma("unroll") for (int k = 0; k < 2; ++k) dst[m][k] = *(const PG8_LAS bf16x8*)(lds + PG8_SA(b, h) + aoff + m * 2048 + k * 1024); } while (0)
#define PG8_LDB(dst, b, h) do { _Pragma("unroll") for (int n = 0; n < 2; ++n) _Pragma("unroll") for (int k = 0; k < 2; ++k) dst[n][k] = *(const PG8_LAS bf16x8*)(lds + PG8_SB(b, h) + boff + n * 2048 + k * 1024); } while (0)
#define PG8_MMA(ai, bj, At, Bt) do { __builtin_amdgcn_s_setprio(1); _Pragma("unroll") for (int m = 0; m < 4; ++m) _Pragma("unroll") for (int n = 0; n < 2; ++n) _Pragma("unroll") for (int k = 0; k < 2; ++k) \
        acc[ai][bj][m][n] = __builtin_amdgcn_mfma_f32_16x16x32_bf16(Bt[n][k], At[m][k], acc[ai][bj][m][n], 0, 0, 0); __builtin_amdgcn_s_setprio(0); } while (0)
#define PG8_WAIT_V(n) asm volatile("s_waitcnt vmcnt(" #n ")" ::: "memory")
#define PG8_WAIT_L(n) asm volatile("s_waitcnt lgkmcnt(" #n ")" ::: "memory")
#define PG8_BAR __builtin_amdgcn_s_barrier()
#define PG8_SCHED __builtin_amdgcn_sched_barrier(0)
    Unit cur, nxt; int ui = 0;
    if (!S.next(0, cur)) return;
    f32x4 acc[2][2][4][2];
#pragma unroll
    for (int a = 0; a < 2; ++a)
#pragma unroll
        for (int b = 0; b < 2; ++b)
#pragma unroll
            for (int m = 0; m < 4; ++m)
#pragma unroll
                for (int n = 0; n < 2; ++n) acc[a][b][m][n] = (f32x4){0.f, 0.f, 0.f, 0.f};
    bf16x8 At[4][2], B0[2][2], B1[2][2];
    const char* cA = (const char*)g.A + (size_t)cur.pm * tstep; const char* cB = (const char*)g.Bt + (size_t)cur.pn * tstep;
    S.a_ready(cur);
    if constexpr (SP2) {
        PG8_STAGE(PG8_SB(0, 0), cB, voffB); PG8_STAGE(PG8_SB(0, 1), cB + hstep, voffB); PG8_STAGE(PG8_SA(0, 0), cA, voffA); PG8_STAGE(PG8_SA(0, 1), cA + hstep, voffA);
        if (wr == 1) PG8_BAR;
        PG8_WAIT_V(2); PG8_BAR;
        PG8_STAGE(PG8_SB(1, 0), cB + kstep, voffB); PG8_STAGE(PG8_SA(1, 0), cA + kstep, voffA); PG8_STAGE(PG8_SB(1, 1), cB + hstep + kstep, voffB);
        PG8_WAIT_V(6); PG8_BAR;
    } else {
        PG8_STAGE(PG8_SB(0, 0), cB, voffB); PG8_STAGE(PG8_SA(0, 0), cA, voffA); PG8_STAGE(PG8_SB(0, 1), cB + hstep, voffB); PG8_STAGE(PG8_SA(0, 1), cA + hstep, voffA);
        if (wr == 1) PG8_BAR;
        PG8_WAIT_V(4); PG8_BAR;
        PG8_STAGE(PG8_SB(1, 0), cB + kstep, voffB); PG8_STAGE(PG8_SA(1, 0), cA + kstep, voffA); PG8_STAGE(PG8_SB(1, 1), cB + hstep + kstep, voffB);
        PG8_WAIT_V(6); PG8_BAR;
    }
    for (;;) {
        const bool has_next = S.next(ui + 1, nxt);
        const char* nA = has_next ? (const char*)g.A + (size_t)nxt.pm * tstep : cA; const char* nB = has_next ? (const char*)g.Bt + (size_t)nxt.pn * tstep : cB;
        for (int t = 0; t < nt; t += 2) {
            const bool last = (t == nt - 2);
            const char* a1 = cA + (size_t)(t + 1) * kstep;
            const char* a2 = last ? nA : cA + (size_t)(t + 2) * kstep; const char* b2 = last ? nB : cB + (size_t)(t + 2) * kstep;
            const char* a3 = a2 + kstep; const char* b3 = b2 + kstep;
            if (last && has_next) S.a_ready(nxt);
            if constexpr (SP2) {
            PG8_LDB(B0, 0, 0); PG8_LDB(B1, 0, 1); PG8_SCHED; PG8_LDA(At, 0, 0); PG8_STAGE(PG8_SA(1, 1), a1 + hstep, voffA);
            PG8_WAIT_V(8); PG8_WAIT_L(0); PG8_BAR; PG8_MMA(0, 0, At, B0); PG8_MMA(0, 1, At, B1); PG8_BAR; PG8_SCHED;
            PG8_LDA(At, 0, 1); PG8_STAGE(PG8_SB(0, 0), b2, voffB); PG8_STAGE(PG8_SB(0, 1), b2 + hstep, voffB); PG8_STAGE(PG8_SA(0, 0), a2, voffA);
            PG8_WAIT_V(8); PG8_WAIT_L(0); PG8_BAR; PG8_MMA(1, 0, At, B0); PG8_MMA(1, 1, At, B1); PG8_BAR; PG8_SCHED;
            PG8_LDB(B0, 1, 0); PG8_LDB(B1, 1, 1); PG8_SCHED; PG8_LDA(At, 1, 0); PG8_STAGE(PG8_SA(0, 1), a2 + hstep, voffA);
            PG8_WAIT_V(8); PG8_WAIT_L(0); PG8_BAR; PG8_MMA(0, 0, At, B0); PG8_MMA(0, 1, At, B1); PG8_BAR; PG8_SCHED;
            PG8_LDA(At, 1, 1); PG8_STAGE(PG8_SB(1, 0), b3, voffB); PG8_STAGE(PG8_SB(1, 1), b3 + hstep, voffB); PG8_STAGE(PG8_SA(1, 0), a3, voffA);
            PG8_WAIT_V(8); PG8_WAIT_L(0); PG8_BAR; PG8_MMA(1, 0, At, B0); PG8_MMA(1, 1, At, B1); PG8_BAR; PG8_SCHED;
            } else {
            PG8_LDB(B0, 0, 0); PG8_SCHED; PG8_LDA(At, 0, 0); PG8_STAGE(PG8_SA(1, 1), a1 + hstep, voffA);
            PG8_WAIT_L(8); PG8_BAR; PG8_WAIT_L(0); PG8_MMA(0, 0, At, B0); PG8_BAR; PG8_SCHED;
            PG8_LDB(B1, 0, 1); PG8_STAGE(PG8_SB(0, 0), b2, voffB);
            PG8_BAR; PG8_WAIT_L(0); PG8_MMA(0, 1, At, B1); PG8_BAR;
            PG8_LDA(At, 0, 1); PG8_STAGE(PG8_SA(0, 0), a2, voffA);
            PG8_BAR; PG8_WAIT_L(0); PG8_MMA(1, 0, At, B0); PG8_BAR; PG8_SCHED;
            PG8_STAGE(PG8_SB(0, 1), b2 + hstep, voffB);
            PG8_WAIT_V(6); PG8_BAR; PG8_MMA(1, 1, At, B1); PG8_BAR;
            PG8_LDB(B0, 1, 0); PG8_SCHED; PG8_LDA(At, 1, 0); PG8_STAGE(PG8_SA(0, 1), a2 + hstep, voffA);
            PG8_WAIT_L(8); PG8_BAR; PG8_WAIT_L(0); PG8_MMA(0, 0, At, B0); PG8_BAR; PG8_SCHED;
            PG8_LDB(B1, 1, 1); PG8_STAGE(PG8_SB(1, 0), b3, voffB);
            PG8_BAR; PG8_WAIT_L(0); PG8_MMA(0, 1, At, B1); PG8_BAR;
            PG8_LDA(At, 1, 1); PG8_STAGE(PG8_SA(1, 0), a3, voffA);
            PG8_BAR; PG8_WAIT_L(0); PG8_MMA(1, 0, At, B0); PG8_BAR; PG8_SCHED;
            PG8_STAGE(PG8_SB(1, 1), b3 + hstep, voffB);
            PG8_WAIT_V(6); PG8_BAR; PG8_MMA(1, 1, At, B1); PG8_BAR;
            }
        }
        if constexpr (ALIGN_EPI) { if (wr == 0) PG8_BAR; }
        if constexpr (!Epi::AFTER_DRAIN) { E(acc, cur, wr, wc, fr, fq); S.done(cur); }
        if (!has_next) break;
#pragma unroll
        for (int a = 0; a < 2; ++a)
#pragma unroll
            for (int b = 0; b < 2; ++b)
#pragma unroll
                for (int m = 0; m < 4; ++m)
#pragma unroll
                    for (int n = 0; n < 2; ++n) acc[a][b][m][n] = (f32x4){0.f, 0.f, 0.f, 0.f};
        cur = nxt; cA = nA; cB = nB; ++ui;
        if constexpr (ALIGN_EPI) { if (wr == 1) PG8_BAR; }
    }
    PG8_WAIT_V(0);
    if constexpr (!ALIGN_EPI) { if (wr == 0) PG8_BAR; }
    PG8_BAR;
    if constexpr (Epi::AFTER_DRAIN) { E.fused(acc, cur, wr, wc, fr, fq, lds, wid, lane); S.done(cur); }
#undef PG8_SA
#undef PG8_SB
#undef PG8_STAGE
#undef PG8_LDA
#undef PG8_LDB
#undef PG8_MMA
#undef PG8_WAIT_V
#undef PG8_WAIT_L
#undef PG8_BAR
#undef PG8_SCHED
}
}
namespace pg8 {
template <class Epi, class Sched, bool ALIGN_EPI = false, bool SP2 = false>
__device__ __forceinline__ void gemm_phase_ga(PG8_LAS unsigned char* lds, const Gemm g, const int* rowidx, const Sched& S, const Epi& E) {
    const int tid = threadIdx.x, wid = __builtin_amdgcn_readfirstlane(tid >> 6), lane = tid & 63, wr = wid >> 2, wc = wid & 3, fr = lane & 15, fq = lane >> 4;
    const int K = g.K, nt = K / BK;
    unsigned voffB[2]; int Ra[2]; unsigned Ca2[2];
#pragma unroll
    for (int i = 0; i < 2; ++i) { int R, C; stage_rc(tid * 16 + i * 8192, R, C); const int Rb = Epi::PERM ? ((R & ~31) + perm32(R & 31)) : R;
        Ra[i] = R; Ca2[i] = (unsigned)C * 2u; voffB[i] = (unsigned)(Rb * K + C) * 2u; }
    const size_t kstep = (size_t)(BK * 2);
    const size_t hstep = (size_t)HALF * K * 2;
    const size_t tstep = 2 * hstep;
    const unsigned ldsw = (unsigned)wid * 1024u;
    const int aoff = lds_byte(wr * 64 + fr, fq * 8), boff = lds_byte(wc * 32 + fr, fq * 8);
#define PG8_SA(b, h) (((b) * 2 + (h)) * HTB)
#define PG8_SB(b, h) ((4 + (b) * 2 + (h)) * HTB)
#define PG8_STAGE(bufoff, gbase, voff) do { _Pragma("unroll") for (int _i = 0; _i < 2; ++_i) \
        __builtin_amdgcn_global_load_lds((const unsigned*)((const char*)(gbase) + (voff)[_i]), (PG8_LAS unsigned*)(lds + (bufoff) + ldsw + _i * 8192), 16, 0, 0); } while (0)
#define PG8_LDA(dst, b, h) do { _Pragma("unroll") for (int m = 0; m < 4; ++m) _Pragma("unroll") for (int k = 0; k < 2; ++k) dst[m][k] = *(const PG8_LAS bf16x8*)(lds + PG8_SA(b, h) + aoff + m * 2048 + k * 1024); } while (0)
#define PG8_LDB(dst, b, h) do { _Pragma("unroll") for (int n = 0; n < 2; ++n) _Pragma("unroll") for (int k = 0; k < 2; ++k) dst[n][k] = *(const PG8_LAS bf16x8*)(lds + PG8_SB(b, h) + boff + n * 2048 + k * 1024); } while (0)
#define PG8_MMA(ai, bj, At, Bt) do { __builtin_amdgcn_s_setprio(1); _Pragma("unroll") for (int m = 0; m < 4; ++m) _Pragma("unroll") for (int n = 0; n < 2; ++n) _Pragma("unroll") for (int k = 0; k < 2; ++k) \
        acc[ai][bj][m][n] = __builtin_amdgcn_mfma_f32_16x16x32_bf16(Bt[n][k], At[m][k], acc[ai][bj][m][n], 0, 0, 0); __builtin_amdgcn_s_setprio(0); } while (0)
#define PG8_WAIT_V(n) asm volatile("s_waitcnt vmcnt(" #n ")" ::: "memory")
#define PG8_WAIT_L(n) asm volatile("s_waitcnt lgkmcnt(" #n ")" ::: "memory")
#define PG8_BAR __builtin_amdgcn_s_barrier()
#define PG8_SCHED __builtin_amdgcn_sched_barrier(0)
    Unit cur, nxt; int ui = 0;
    if (!S.next(0, cur)) return;
    f32x4 acc[2][2][4][2];
#pragma unroll
    for (int a = 0; a < 2; ++a)
#pragma unroll
        for (int b = 0; b < 2; ++b)
#pragma unroll
            for (int m = 0; m < 4; ++m)
#pragma unroll
                for (int n = 0; n < 2; ++n) acc[a][b][m][n] = (f32x4){0.f, 0.f, 0.f, 0.f};
    bf16x8 At[4][2], B0[2][2], B1[2][2];
#define PG8_GAROWS(u, dst) do { _Pragma("unroll") for (int h_ = 0; h_ < 2; ++h_) _Pragma("unroll") for (int i_ = 0; i_ < 2; ++i_) dst[h_][i_] = (unsigned)rowidx[(u).pm * BM + h_ * HALF + Ra[i_]] * (unsigned)(K * 2) + Ca2[i_]; } while (0)
    unsigned vc[2][2], vn[2][2];
    PG8_GAROWS(cur, vc);
    const char* cA = (const char*)g.A; const char* cB = (const char*)g.Bt + (size_t)cur.pn * tstep;
    S.a_ready(cur);
    if constexpr (SP2) {
        PG8_STAGE(PG8_SB(0, 0), cB, voffB); PG8_STAGE(PG8_SB(0, 1), cB + hstep, voffB); PG8_STAGE(PG8_SA(0, 0), cA, vc[0]); PG8_STAGE(PG8_SA(0, 1), cA, vc[1]);
        if (wr == 1) PG8_BAR;
        PG8_WAIT_V(2); PG8_BAR;
        PG8_STAGE(PG8_SB(1, 0), cB + kstep, voffB); PG8_STAGE(PG8_SA(1, 0), cA + kstep, vc[0]); PG8_STAGE(PG8_SB(1, 1), cB + hstep + kstep, voffB);
        PG8_WAIT_V(6); PG8_BAR;
    } else {
        PG8_STAGE(PG8_SB(0, 0), cB, voffB); PG8_STAGE(PG8_SA(0, 0), cA, vc[0]); PG8_STAGE(PG8_SB(0, 1), cB + hstep, voffB); PG8_STAGE(PG8_SA(0, 1), cA, vc[1]);
        if (wr == 1) PG8_BAR;
        PG8_WAIT_V(4); PG8_BAR;
        PG8_STAGE(PG8_SB(1, 0), cB + kstep, voffB); PG8_STAGE(PG8_SA(1, 0), cA + kstep, vc[0]); PG8_STAGE(PG8_SB(1, 1), cB + hstep + kstep, voffB);
        PG8_WAIT_V(6); PG8_BAR;
    }
    for (;;) {
        const bool has_next = S.next(ui + 1, nxt);
        if (has_next) { PG8_GAROWS(nxt, vn); } else { _Pragma("unroll") for (int h_ = 0; h_ < 2; ++h_) _Pragma("unroll") for (int i_ = 0; i_ < 2; ++i_) vn[h_][i_] = vc[h_][i_]; }
        const char* nB = has_next ? (const char*)g.Bt + (size_t)nxt.pn * tstep : cB;
        for (int t = 0; t < nt; t += 2) {
            const bool last = (t == nt - 2);
            const char* a1 = cA + (size_t)(t + 1) * kstep;
            unsigned w0[2], w1[2];
            _Pragma("unroll") for (int i_ = 0; i_ < 2; ++i_) { w0[i_] = last ? vn[0][i_] : vc[0][i_]; w1[i_] = last ? vn[1][i_] : vc[1][i_]; }
            const char* a2 = last ? cA : cA + (size_t)(t + 2) * kstep; const char* b2 = last ? nB : cB + (size_t)(t + 2) * kstep;
            const char* a3 = a2 + kstep; const char* b3 = b2 + kstep;
            if (last && has_next) S.a_ready(nxt);
            if constexpr (SP2) {
            PG8_LDB(B0, 0, 0); PG8_LDB(B1, 0, 1); PG8_SCHED; PG8_LDA(At, 0, 0); PG8_STAGE(PG8_SA(1, 1), a1, vc[1]);
            PG8_WAIT_V(8); PG8_WAIT_L(0); PG8_BAR; PG8_MMA(0, 0, At, B0); PG8_MMA(0, 1, At, B1); PG8_BAR; PG8_SCHED;
            PG8_LDA(At, 0, 1); PG8_STAGE(PG8_SB(0, 0), b2, voffB); PG8_STAGE(PG8_SB(0, 1), b2 + hstep, voffB); PG8_STAGE(PG8_SA(0, 0), a2, w0);
            PG8_WAIT_V(8); PG8_WAIT_L(0); PG8_BAR; PG8_MMA(1, 0, At, B0); PG8_MMA(1, 1, At, B1); PG8_BAR; PG8_SCHED;
            PG8_LDB(B0, 1, 0); PG8_LDB(B1, 1, 1); PG8_SCHED; PG8_LDA(At, 1, 0); PG8_STAGE(PG8_SA(0, 1), a2, w1);
            PG8_WAIT_V(8); PG8_WAIT_L(0); PG8_BAR; PG8_MMA(0, 0, At, B0); PG8_MMA(0, 1, At, B1); PG8_BAR; PG8_SCHED;
            PG8_LDA(At, 1, 1); PG8_STAGE(PG8_SB(1, 0), b3, voffB); PG8_STAGE(PG8_SB(1, 1), b3 + hstep, voffB); PG8_STAGE(PG8_SA(1, 0), a3, w0);
            PG8_WAIT_V(8); PG8_WAIT_L(0); PG8_BAR; PG8_MMA(1, 0, At, B0); PG8_MMA(1, 1, At, B1); PG8_BAR; PG8_SCHED;
            } else {
            PG8_LDB(B0, 0, 0); PG8_SCHED; PG8_LDA(At, 0, 0); PG8_STAGE(PG8_SA(1, 1), a1, vc[1]);
            PG8_WAIT_L(8); PG8_BAR; PG8_WAIT_L(0); PG8_MMA(0, 0, At, B0); PG8_BAR; PG8_SCHED;
            PG8_LDB(B1, 0, 1); PG8_STAGE(PG8_SB(0, 0), b2, voffB);
            PG8_BAR; PG8_WAIT_L(0); PG8_MMA(0, 1, At, B1); PG8_BAR;
            PG8_LDA(At, 0, 1); PG8_STAGE(PG8_SA(0, 0), a2, w0);
            PG8_BAR; PG8_WAIT_L(0); PG8_MMA(1, 0, At, B0); PG8_BAR; PG8_SCHED;
            PG8_STAGE(PG8_SB(0, 1), b2 + hstep, voffB);
            PG8_WAIT_V(6); PG8_BAR; PG8_MMA(1, 1, At, B1); PG8_BAR;
            PG8_LDB(B0, 1, 0); PG8_SCHED; PG8_LDA(At, 1, 0); PG8_STAGE(PG8_SA(0, 1), a2, w1);
            PG8_WAIT_L(8); PG8_BAR; PG8_WAIT_L(0); PG8_MMA(0, 0, At, B0); PG8_BAR; PG8_SCHED;
            PG8_LDB(B1, 1, 1); PG8_STAGE(PG8_SB(1, 0), b3, voffB);
            PG8_BAR; PG8_WAIT_L(0); PG8_MMA(0, 1, At, B1); PG8_BAR;
            PG8_LDA(At, 1, 1); PG8_STAGE(PG8_SA(1, 0), a3, w0);
            PG8_BAR; PG8_WAIT_L(0); PG8_MMA(1, 0, At, B0); PG8_BAR; PG8_SCHED;
            PG8_STAGE(PG8_SB(1, 1), b3 + hstep, voffB);
            PG8_WAIT_V(6); PG8_BAR; PG8_MMA(1, 1, At, B1); PG8_BAR;
            }
        }
        if constexpr (ALIGN_EPI) { if (wr == 0) PG8_BAR; }
        if constexpr (!Epi::AFTER_DRAIN) { E(acc, cur, wr, wc, fr, fq); S.done(cur); }
        if (!has_next) break;
#pragma unroll
        for (int a = 0; a < 2; ++a)
#pragma unroll
            for (int b = 0; b < 2; ++b)
#pragma unroll
                for (int m = 0; m < 4; ++m)
#pragma unroll
                    for (int n = 0; n < 2; ++n) acc[a][b][m][n] = (f32x4){0.f, 0.f, 0.f, 0.f};
        cur = nxt; cB = nB; ++ui;
        _Pragma("unroll") for (int h_ = 0; h_ < 2; ++h_) _Pragma("unroll") for (int i_ = 0; i_ < 2; ++i_) vc[h_][i_] = vn[h_][i_];
        if constexpr (ALIGN_EPI) { if (wr == 1) PG8_BAR; }
    }
    PG8_WAIT_V(0);
    if constexpr (!ALIGN_EPI) { if (wr == 0) PG8_BAR; }
    PG8_BAR;
    if constexpr (Epi::AFTER_DRAIN) { E.fused(acc, cur, wr, wc, fr, fq, lds, wid, lane); S.done(cur); }
#undef PG8_SA
#undef PG8_SB
#undef PG8_STAGE
#undef PG8_LDA
#undef PG8_LDB
#undef PG8_MMA
#undef PG8_WAIT_V
#undef PG8_WAIT_L
#undef PG8_BAR
#undef PG8_SCHED
#undef PG8_GAROWS
}
}
#define MK_N_LAUNCHES 1
constexpr int NPHASE = 11;
constexpr int T = 8192, DM = 2048, SEQ = 2048;
constexpr int NPROJ = 6144, DIN = 6160;
constexpr int NEXP = 32, FFE = 512;
constexpr float EPS = 1e-6f;
constexpr float C2 = 0.125f * 1.4426950408889634f;
constexpr float QSCALE_GLA = 0.08838834764831845f;
constexpr float LAMBDA_INIT = 0.2f;
constexpr int NWAVES = 8;

constexpr size_t MiB = 1u << 20;
constexpr size_t WS_CTL = 0, CTL_ZERO_BYTES = 1 * MiB;
constexpr size_t WS_WIN_T = 1 * MiB;
constexpr size_t WS_WOUT_T = 25 * MiB;
constexpr size_t WS_WGU_T = 33 * MiB;
constexpr size_t WS_WD_T = 161 * MiB;
constexpr size_t WS_XN = 225 * MiB;
constexpr size_t WS_PROJ = 257 * MiB;
constexpr size_t WS_MIX = 353 * MiB;
constexpr size_t WS_H = 385 * MiB;
constexpr size_t WS_U = 409 * MiB;
constexpr size_t WS_ST = 473 * MiB;
constexpr size_t WS_GA = 505 * MiB;
constexpr size_t WS_CS = WS_GA + 512 * 1024;
constexpr size_t WS_DEC = WS_CS + 512 * 1024;
constexpr size_t WS_TOKE = WS_DEC + 256 * 1024;
constexpr size_t WS_TOKR = WS_TOKE + 64 * 1024;
constexpr size_t WS_TOKW = WS_TOKR + 64 * 1024;
constexpr size_t WS_TILE = WS_TOKW + 64 * 1024;
constexpr size_t WS_WR = WS_TILE + 64 * 1024;
constexpr size_t WS_WCNT = WS_WR + 320 * 1024;
constexpr size_t WS_TOKP = WS_WCNT + 64 * 1024;
constexpr size_t WS_TOKS = WS_TOKP + 64 * 1024;
constexpr size_t WS_RS = WS_TOKS + 64 * 1024;
constexpr size_t WS_ROWTOK = WS_RS + 128 * 1024;
constexpr int MAXROWS = 24576;
constexpr size_t WS_END = 508 * MiB;
constexpr int CW_CNT = 64;
constexpr int CW_BAR = 4096;

#define GAS __attribute__((address_space(1)))
#define LAS __attribute__((address_space(3)))
typedef unsigned short bf16;
typedef unsigned v4u __attribute__((ext_vector_type(4)));
typedef unsigned v2u __attribute__((ext_vector_type(2)));
typedef float f32x4 __attribute__((ext_vector_type(4)));
typedef float f32x16 __attribute__((ext_vector_type(16)));
typedef float f32x2 __attribute__((ext_vector_type(2)));
typedef short bf16x8 __attribute__((ext_vector_type(8)));
typedef short s16x4 __attribute__((ext_vector_type(4)));
typedef LAS unsigned char* ldsp;
#define LDS_WAIT() asm volatile("s_waitcnt lgkmcnt(0)" ::: "memory")
__device__ __forceinline__ unsigned f2bf(float f) { unsigned u = __builtin_bit_cast(unsigned, f); return (u + 0x7fffu + ((u >> 16) & 1u)) >> 16; }
__device__ __forceinline__ unsigned pk2(float lo, float hi) { return pg8::cvt_pk_bf16(lo, hi); }
__device__ __forceinline__ float bf2f(unsigned short b) { return __builtin_bit_cast(float, (unsigned)b << 16); }
__device__ __forceinline__ float bflo(unsigned u) { return __builtin_bit_cast(float, u << 16); }
__device__ __forceinline__ float bfhi(unsigned u) { return __builtin_bit_cast(float, u & 0xffff0000u); }
__device__ __forceinline__ int crow(int r, int hh) { return (r & 3) + 8 * (r >> 2) + 4 * hh; }
__device__ __forceinline__ s16x4 vtr(const LAS unsigned char* p) { return __builtin_bit_cast(s16x4, __builtin_amdgcn_ds_read_tr16_b64_v4i16((LAS s16x4*)p)); }
__device__ __forceinline__ bf16x8 cat8(s16x4 a, s16x4 b) { return (bf16x8){a[0], a[1], a[2], a[3], b[0], b[1], b[2], b[3]}; }
__device__ __forceinline__ bf16x8 pack8(const f32x16& p, int b0) {
    v4u w; w.x = pk2(p[b0], p[b0 + 1]); w.y = pk2(p[b0 + 2], p[b0 + 3]); w.z = pk2(p[b0 + 4], p[b0 + 5]); w.w = pk2(p[b0 + 6], p[b0 + 7]);
    return __builtin_bit_cast(bf16x8, w);
}
#define MFMA32(a, b, c) __builtin_amdgcn_mfma_f32_32x32x16_bf16((a), (b), (c), 0, 0, 0)

#define XB_TMO      128
#define XB_XCNT(j)  (256  + 64 * (j))
#define XB_XSUB(j)  (1280 + 64 * (j))
#define XB_XGEN(j)  (2304 + 64 * (j))
#define XB_TOP      3328
#define XB_TOPGEN   3392
#define XCD_BAR_WORDS 3456
#define XB_SPIN_CAP (1u << 18)

__device__ __forceinline__ unsigned xb_ld(unsigned* p)              { return __hip_atomic_load(p, __ATOMIC_RELAXED, __HIP_MEMORY_SCOPE_AGENT); }
__device__ __forceinline__ unsigned xb_add(unsigned* p, unsigned v) { return __hip_atomic_fetch_add(p, v, __ATOMIC_RELAXED, __HIP_MEMORY_SCOPE_AGENT); }
__device__ __forceinline__ unsigned xb_xcc_id() { return (unsigned)__builtin_amdgcn_s_getreg((3 << 11) | 20) & 0xFu; }
#define XB_SPIN(cond, bar) do { unsigned _sp = 0; while (cond) { __builtin_amdgcn_s_sleep(1); \
    if ((++_sp & 255u) == 0u) { if (xb_ld(&(bar)[XB_TMO])) break; if (_sp > XB_SPIN_CAP) { atomicAdd(&(bar)[XB_TMO], 1u); break; } } } } while (0)

struct XcdBarrier {
    unsigned* bar; unsigned x;
    volatile LAS unsigned* st;
};

__device__ __forceinline__ XcdBarrier xcd_barrier_post(unsigned* bar, volatile LAS unsigned* st) {
    XcdBarrier b; b.bar = bar; b.x = xb_xcc_id(); b.st = st;
    if (threadIdx.x == 0) (void)xb_add(&bar[XB_XCNT(b.x)], 1u);
    return b;
}
__device__ __forceinline__ void xcd_barrier_complete(unsigned* bar, unsigned x, unsigned& nloc, unsigned& nx) {
    const unsigned G = gridDim.x * gridDim.y * gridDim.z;
    unsigned sum, cnt, mine, sp = 0u;
    for (;;) {
        sum = 0u; cnt = 0u; mine = 0u;
#pragma unroll
        for (unsigned j = 0; j < 16; ++j) { const unsigned c = xb_ld(&bar[XB_XCNT(j)]); sum += c; cnt += (c > 0u) ? 1u : 0u; mine = (j == x) ? c : mine; }
        if (sum == G) break;
        __builtin_amdgcn_s_sleep(1);
        if ((++sp & 255u) == 0u) { if (xb_ld(&bar[XB_TMO])) break; if (sp > XB_SPIN_CAP) { atomicAdd(&bar[XB_TMO], 1u); break; } }
    }
    nloc = mine > 0u ? mine : 1u; nx = cnt > 0u ? cnt : 1u;
}

__device__ __forceinline__ void xcd_barrier(const XcdBarrier& b) {
    asm volatile("s_waitcnt vmcnt(0)" ::: "memory");
    __syncthreads();
    if (threadIdx.x == 0) {
        unsigned* bar = b.bar;
        __builtin_amdgcn_s_waitcnt(0);
        unsigned nloc = b.st[0], nx = b.st[1];
        if (nloc == 0u) { xcd_barrier_complete(bar, b.x, nloc, nx); b.st[0] = nloc; b.st[1] = nx; }
        const unsigned old = xb_add(&bar[XB_XSUB(b.x)], 1u);
        const unsigned gen = old / nloc;
        if (old + 1u == (gen + 1u) * nloc) {
            __builtin_amdgcn_fence(__ATOMIC_RELEASE, "agent");
            asm volatile("s_waitcnt vmcnt(0)" ::: "memory");
            const unsigned og = xb_add(&bar[XB_TOP], 1u);
            const unsigned tg = og / nx;
            if (og + 1u == (tg + 1u) * nx) xb_add(&bar[XB_TOPGEN], 1u);
            else XB_SPIN(xb_ld(&bar[XB_TOPGEN]) == tg, bar);
            __builtin_amdgcn_fence(__ATOMIC_ACQUIRE, "agent");
            xb_add(&bar[XB_XGEN(b.x)], 1u);
            asm volatile("s_waitcnt vmcnt(0)" ::: "memory");
        } else {
            XB_SPIN(xb_ld(&bar[XB_XGEN(b.x)]) == gen, bar);
            __builtin_amdgcn_fence(__ATOMIC_ACQUIRE, "agent");
            asm volatile("s_waitcnt vmcnt(0)" ::: "memory");
        }
    }
    __syncthreads();
}


struct Args { const float* in[23]; float* out; unsigned char* ws; float invf[8]; int ph_lo, ph_hi; };
struct Frame {
    ldsp lds; int tid, lane, wave, vcu, G;
};

__device__ __forceinline__ void tr_item64(const float* W, size_t pitch, int k0, int n0, bf16* WT, int Kdst, int drow0, int drow1, LAS float* scr, int lane) {
    const int kr = lane >> 4, nq = lane & 15;
    f32x4 v[16];
#pragma unroll
    for (int i = 0; i < 16; ++i) v[i] = *(const f32x4*)(W + (size_t)(k0 + 4 * i + kr) * pitch + n0 + 4 * nq);
#pragma unroll
    for (int i = 0; i < 16; ++i) { LAS float* d = scr + (4 * i + kr) * 65 + 4 * nq; d[0] = v[i].x; d[1] = v[i].y; d[2] = v[i].z; d[3] = v[i].w; }
    LDS_WAIT();
    const int c = lane & 7;
#pragma unroll
    for (int j = 0; j < 8; ++j) { const int n = (lane >> 3) + 8 * j; const LAS float* s = scr + (8 * c) * 65 + n;
        v4u o; o.x = pk2(s[0 * 65], s[1 * 65]); o.y = pk2(s[2 * 65], s[3 * 65]); o.z = pk2(s[4 * 65], s[5 * 65]); o.w = pk2(s[6 * 65], s[7 * 65]);
        const int drow = (n < 32) ? drow0 + n : drow1 + n - 32;
        *(v4u*)(WT + (size_t)drow * Kdst + k0 + 8 * c) = o; }
    LDS_WAIT();
}
__device__ __forceinline__ float wave_sum(float v) {
#pragma unroll
    for (int o = 1; o < 64; o <<= 1) v += __shfl_xor(v, o);
    return v;
}
__device__ __forceinline__ void p0_prologue(const Frame& F, const Args& A) {
    unsigned char* ws = A.ws;
    const int gw = F.vcu * NWAVES + F.wave, NGW = F.G * NWAVES;
    {
        const int* pos = (const int*)A.in[1]; float* cs = (float*)(ws + WS_CS);
        for (int t = blockIdx.x * 512 + F.tid; t < T; t += F.G * 512) {
            const double p = (double)pos[t];
#pragma unroll
            for (int i = 0; i < 8; ++i) {
                const double a = p * (double)A.invf[i] * 0.15915494309189535;
                const float fr = (float)(a - floor(a));
                cs[t * 16 + i] = __builtin_amdgcn_cosf(fr); cs[t * 16 + 8 + i] = __builtin_amdgcn_sinf(fr);
            }
        }
    }
    {
        const float* g2 = A.in[15]; const float* wrg = A.in[16]; const float* wre = A.in[18]; float* WR = (float*)(ws + WS_WR);
        for (int g = blockIdx.x * 512 + F.tid; g < 2048 * 36; g += F.G * 512) {
            const int j = g % 36, rq = g / 36, rho = rq & 511, q = rq >> 9;
            const int l = rho & 63, c = (rho >> 6) & 3, i = rho >> 8, kk = q * 512 + 4 * l + 256 * i + c;
            const float wv = (j < 4) ? wrg[kk * 4 + j] : wre[(size_t)((j - 4) >> 3) * (DM * 8) + kk * 8 + ((j - 4) & 7)];
            WR[g] = wv * g2[kk];
        }
    }
    {
        const float* x = A.in[0]; const float* g1 = A.in[2]; const float* win = A.in[3];
        bf16* XN = (bf16*)(ws + WS_XN); float* GA = (float*)(ws + WS_GA);
        LAS float* wl = (LAS float*)F.lds;
        for (int idx = F.tid; idx < 2048 * 16; idx += 512) {
            const int k = idx >> 4, r = idx & 15; const int lk = (k & 255) >> 2, i = k & 3, j = k >> 8;
            wl[((((j * 4 + i) * 4 + (r >> 2)) * 64 + lk) << 2) + (r & 3)] = win[(size_t)k * DIN + NPROJ + r];
        }
        __syncthreads();
        for (int rg = gw; rg < T / 2; rg += NGW) {
            float rstd[2];
            {
                f32x4 xv[2][8]; float ss[2];
#pragma unroll
                for (int rr = 0; rr < 2; ++rr) { ss[rr] = 0.f;
#pragma unroll
                    for (int j = 0; j < 8; ++j) { xv[rr][j] = *(const f32x4*)(x + (size_t)(rg * 2 + rr) * DM + 4 * F.lane + 256 * j); const f32x4 q = xv[rr][j] * xv[rr][j]; ss[rr] += (q.x + q.y) + (q.z + q.w); } }
#pragma unroll
                for (int rr = 0; rr < 2; ++rr) { ss[rr] = wave_sum(ss[rr]); rstd[rr] = 1.0f / sqrtf(ss[rr] * (1.0f / DM) + EPS);
#pragma unroll
                    for (int j = 0; j < 8; ++j) { const f32x4 g4 = *(const f32x4*)(g1 + 4 * F.lane + 256 * j); const f32x4 y = xv[rr][j] * rstd[rr] * g4;
                        v2u o; o.x = pk2(y.x, y.y); o.y = pk2(y.z, y.w);
                        *(v2u*)(XN + (size_t)(rg * 2 + rr) * DM + 4 * F.lane + 256 * j) = o; } }
            }
            f32x4 acc[2][4];
#pragma unroll
            for (int rr = 0; rr < 2; ++rr)
#pragma unroll
                for (int q = 0; q < 4; ++q) acc[rr][q] = (f32x4){0.f, 0.f, 0.f, 0.f};
#pragma unroll 1
            for (int j = 0; j < 8; ++j) {
                const f32x4 g4 = *(const f32x4*)(g1 + 4 * F.lane + 256 * j);
                f32x4 xj[2];
#pragma unroll
                for (int rr = 0; rr < 2; ++rr) xj[rr] = *(const f32x4*)(x + (size_t)(rg * 2 + rr) * DM + 4 * F.lane + 256 * j) * rstd[rr] * g4;
#pragma unroll
                for (int i = 0; i < 4; ++i)
#pragma unroll
                    for (int rq = 0; rq < 4; ++rq) { const f32x4 w4 = *(const LAS f32x4*)(wl + ((((j * 4 + i) * 4 + rq) * 64 + F.lane) << 2));
#pragma unroll
                        for (int rr = 0; rr < 2; ++rr) acc[rr][rq] += w4 * xj[rr][i]; }
            }
#pragma unroll
            for (int rr = 0; rr < 2; ++rr)
#pragma unroll
                for (int rq = 0; rq < 4; ++rq) { f32x4 a = acc[rr][rq]; a.x = wave_sum(a.x); a.y = wave_sum(a.y); a.z = wave_sum(a.z); a.w = wave_sum(a.w);
                    if (F.lane == 0) *(f32x4*)(GA + (size_t)(rg * 2 + rr) * 16 + rq * 4) = a; }
        }
        __syncthreads();
    }
    {
        LAS float* scr = (LAS float*)(F.lds + F.wave * 16640);
        const float* win = A.in[3]; const float* wout = A.in[14]; const float* wg = A.in[20]; const float* wu = A.in[21]; const float* wd = A.in[22];
        bf16* WinT = (bf16*)(ws + WS_WIN_T); bf16* WoutT = (bf16*)(ws + WS_WOUT_T); bf16* WguT = (bf16*)(ws + WS_WGU_T); bf16* WdT = (bf16*)(ws + WS_WD_T);
        constexpr int I_IN = 32 * 96, I_OUT = 32 * 32;
        for (int it = gw; it < I_IN + I_OUT; it += NGW) {
            int r = it;
            if (r < I_IN) { const int kb = r / 96, nb = r % 96; int d0 = nb * 64, d1 = nb * 64 + 32;
                if (nb < 32) { const int sec = nb >> 4, s = nb & 15; d0 = sec * 1024 + (s >> 2) * 256 + (s & 3) * 32; d1 = d0 + 128; }
                tr_item64(win, DIN, kb * 64, nb * 64, WinT, DM, d0, d1, scr, F.lane); continue; }
            r -= I_IN;
            if (r < I_OUT) { const int kb = r >> 5, nb = r & 31; tr_item64(wout, DM, kb * 64, nb * 64, WoutT, DM, nb * 64, nb * 64 + 32, scr, F.lane); continue; }
        }
    }
}

struct TrDesc { const float* src; size_t pitch; bf16* dst; int Kdst, d0, d1; };
__device__ __forceinline__ void tr_load(const TrDesc& d, f32x4 (&v)[16], int lane) {
    const int kr = lane >> 4, nq = lane & 15;
#pragma unroll
    for (int i = 0; i < 16; ++i) v[i] = __builtin_nontemporal_load((const f32x4*)(d.src + (size_t)(4 * i + kr) * d.pitch + 4 * nq));
}
__device__ __forceinline__ void tr_stash(const f32x4 (&v)[16], LAS float* scr, int lane) {
    const int kr = lane >> 4, nq = lane & 15;
#pragma unroll
    for (int i = 0; i < 16; ++i) { LAS float* p = scr + (4 * i + kr) * 65 + 4 * nq; p[0] = v[i].x; p[1] = v[i].y; p[2] = v[i].z; p[3] = v[i].w; }
}
__device__ __forceinline__ void tr_flush(const TrDesc& d, LAS float* scr, int lane) {
    LDS_WAIT();
    const int c = lane & 7;
#pragma unroll
    for (int j = 0; j < 8; ++j) { const int n = (lane >> 3) + 8 * j; const LAS float* s = scr + (8 * c) * 65 + n;
        v4u o; o.x = pk2(s[0 * 65], s[1 * 65]); o.y = pk2(s[2 * 65], s[3 * 65]); o.z = pk2(s[4 * 65], s[5 * 65]); o.w = pk2(s[6 * 65], s[7 * 65]);
        const int drow = (n < 32) ? d.d0 + n : d.d1 + n - 32;
        __builtin_nontemporal_store(o, (v4u*)(d.dst + (size_t)drow * d.Kdst + 8 * c)); }
    LDS_WAIT();
}
constexpr int I_GATEUP = 2 * 32 * 32 * 8;
__device__ __forceinline__ TrDesc tr_desc_gateup(int r, const float* wg, const float* wu, bf16* WguT) {
    const int nb = r & 7, kb = (r >> 3) & 31, up = (r >> 8) & 1, e = r >> 9; const int n0 = nb * 64; const int d0 = e * 1024 + (n0 >> 7) * 256 + up * 128 + (n0 & 127);
    return TrDesc{(up ? wu : wg) + (size_t)e * DM * FFE + (size_t)(kb * 64) * FFE + n0, (size_t)FFE, WguT + kb * 64, DM, d0, d0 + 32};
}
constexpr int I_DOWN = 32 * 8 * 32;
__device__ __forceinline__ TrDesc tr_desc_down(int r, const float* wd, bf16* WdT) {
    const int nb = r & 31, kb = (r >> 5) & 7, e = r >> 8;
    return TrDesc{wd + (size_t)e * FFE * DM + (size_t)(kb * 64) * DM + nb * 64, (size_t)DM, WdT + kb * 64, FFE, e * 2048 + nb * 64, e * 2048 + nb * 64 + 32};
}
#define TR_STREAM(DESC_EXPR, it0, step, n, scr, lane) do { int ia_ = (it0), ib_ = (it0) + (step); f32x4 va_[16], vb_[16]; TrDesc da_, db_; \
        if (ia_ < (n)) { da_ = DESC_EXPR(ia_); tr_load(da_, va_, lane); } if (ib_ < (n)) { db_ = DESC_EXPR(ib_); tr_load(db_, vb_, lane); } \
        while (ia_ < (n)) { \
            { tr_stash(va_, scr, lane); const TrDesc dc_ = da_; ia_ += 2 * (step); if (ia_ < (n)) { da_ = DESC_EXPR(ia_); tr_load(da_, va_, lane); } tr_flush(dc_, scr, lane); } \
            if (ib_ < (n)) { tr_stash(vb_, scr, lane); const TrDesc dc_ = db_; ib_ += 2 * (step); if (ib_ < (n)) { db_ = DESC_EXPR(ib_); tr_load(db_, vb_, lane); } tr_flush(dc_, scr, lane); } \
        } } while (0)

struct EpiProj {
    static constexpr bool PERM = true, AFTER_DRAIN = false;
    bf16* proj; const float* cs; const float* qg; const float* kg;
    __device__ __forceinline__ void operator()(const pg8::f32x4 (&acc)[2][2][4][2], const pg8::Unit& u, int wr, int wc, int fr, int fq) const {
        const int row0 = u.pm * 256 + wr * 64 + fr;
        if (u.pn < 8) {
            const bool isq = u.pn < 4;
            const float* gp = isq ? qg : kg;
            bf16* base = proj + (isq ? (size_t)0 : (size_t)T * 1024) + ((u.pn & 3) * 4 + wc) * 64 + 8 * fq;
            f32x4 g[2][2];
#pragma unroll
            for (int bj = 0; bj < 2; ++bj)
#pragma unroll
                for (int n = 0; n < 2; ++n) g[bj][n] = *(const f32x4*)(gp + 32 * bj + 8 * fq + 4 * n);
            const float osc = isq ? C2 : 1.0f;
            const float sgn = (fq == 0) ? -1.0f : 1.0f;
#pragma unroll
            for (int ai = 0; ai < 2; ++ai)
#pragma unroll
                for (int m = 0; m < 4; ++m) {
                    const int row = row0 + ai * 128 + m * 16;
                    f32x4 v[2][2]; float ss = 0.f;
#pragma unroll
                    for (int bj = 0; bj < 2; ++bj)
#pragma unroll
                        for (int n = 0; n < 2; ++n) { v[bj][n] = acc[ai][bj][m][n]; const f32x4 q = v[bj][n] * v[bj][n]; ss += (q.x + q.y) + (q.z + q.w); }
                    ss += __shfl_xor(ss, 16); ss += __shfl_xor(ss, 32);
                    const float rstd = 1.0f / sqrtf(ss * (1.0f / 64.0f) + EPS);
#pragma unroll
                    for (int bj = 0; bj < 2; ++bj)
#pragma unroll
                        for (int n = 0; n < 2; ++n) v[bj][n] = v[bj][n] * rstd * g[bj][n];
                    f32x4 o0, o1;
                    o0.x = __shfl_xor(v[0][0].x, 16); o0.y = __shfl_xor(v[0][0].y, 16); o0.z = __shfl_xor(v[0][0].z, 16); o0.w = __shfl_xor(v[0][0].w, 16);
                    o1.x = __shfl_xor(v[0][1].x, 16); o1.y = __shfl_xor(v[0][1].y, 16); o1.z = __shfl_xor(v[0][1].z, 16); o1.w = __shfl_xor(v[0][1].w, 16);
                    if (fq < 2) {
                        const f32x4 c0 = *(const f32x4*)(cs + (size_t)row * 16), c1 = *(const f32x4*)(cs + (size_t)row * 16 + 4);
                        const f32x4 s0 = *(const f32x4*)(cs + (size_t)row * 16 + 8), s1 = *(const f32x4*)(cs + (size_t)row * 16 + 12);
                        v[0][0] = v[0][0] * c0 + o0 * s0 * sgn; v[0][1] = v[0][1] * c1 + o1 * s1 * sgn;
                    }
#pragma unroll
                    for (int bj = 0; bj < 2; ++bj) { const f32x4 a = v[bj][0] * osc, b = v[bj][1] * osc;
                        v4u w; w.x = pk2(a.x, a.y); w.y = pk2(a.z, a.w); w.z = pk2(b.x, b.y); w.w = pk2(b.z, b.w);
                        *(v4u*)(base + (size_t)row * 1024 + 32 * bj) = w; }
                }
        } else {
            int ld, ct; size_t off;
            if (u.pn < 12)      { off = (size_t)2 * T * 1024;            ld = 1024; ct = u.pn - 8; }
            else if (u.pn < 14) { off = (size_t)3 * T * 1024;            ld = 512;  ct = u.pn - 12; }
            else if (u.pn < 16) { off = (size_t)3 * T * 1024 + T * 512;  ld = 512;  ct = u.pn - 14; }
            else if (u.pn < 20) { off = (size_t)4 * T * 1024;            ld = 1024; ct = u.pn - 16; }
            else                { off = (size_t)5 * T * 1024;            ld = 1024; ct = u.pn - 20; }
            bf16* base = proj + off + ct * 256 + wc * 32 + 8 * fq;
#pragma unroll
            for (int ai = 0; ai < 2; ++ai)
#pragma unroll
                for (int m = 0; m < 4; ++m) { bf16* rowp = base + (size_t)(row0 + ai * 128 + m * 16) * ld;
#pragma unroll
                    for (int bj = 0; bj < 2; ++bj) { const f32x4 a = acc[ai][bj][m][0], b = acc[ai][bj][m][1];
                        v4u w; w.x = pk2(a.x, a.y); w.y = pk2(a.z, a.w); w.z = pk2(b.x, b.y); w.w = pk2(b.z, b.w);
                        *(v4u*)(rowp + bj * 128) = w; } }
        }
    }
};
struct EpiOut {
    static constexpr bool PERM = false, AFTER_DRAIN = false;
    const float* x; float* out;
    __device__ __forceinline__ void operator()(const pg8::f32x4 (&acc)[2][2][4][2], const pg8::Unit& u, int wr, int wc, int fr, int fq) const {
        const int row0 = u.pm * 256 + wr * 64 + fr, col0 = u.pn * 256 + wc * 32 + 4 * fq;
#pragma unroll
        for (int ai = 0; ai < 2; ++ai)
#pragma unroll
            for (int m = 0; m < 4; ++m) { const size_t ro = (size_t)(row0 + ai * 128 + m * 16) * DM + col0;
#pragma unroll
                for (int bj = 0; bj < 2; ++bj)
#pragma unroll
                    for (int n = 0; n < 2; ++n) { const size_t o = ro + bj * 128 + n * 16; *(f32x4*)(out + o) = *(const f32x4*)(x + o) + acc[ai][bj][m][n]; } }
    }
};
struct EpiG1 {
    static constexpr bool PERM = true, AFTER_DRAIN = false;
    bf16* H; const float* RS;
    __device__ __forceinline__ void operator()(const pg8::f32x4 (&acc)[2][2][4][2], const pg8::Unit& u, int wr, int wc, int fr, int fq) const {
        const int row0 = u.pm * 256 + wr * 64 + fr, col0 = (u.pn & 3) * 128 + wc * 32 + 8 * fq;
#pragma unroll
        for (int ai = 0; ai < 2; ++ai)
#pragma unroll
            for (int m = 0; m < 4; ++m) { float hv[8]; const float rs = RS[row0 + ai * 128 + m * 16];
#pragma unroll
                for (int n = 0; n < 2; ++n)
#pragma unroll
                    for (int j = 0; j < 4; ++j) { const float g = acc[ai][0][m][n][j] * rs, up = acc[ai][1][m][n][j] * rs; hv[n * 4 + j] = g / (1.0f + __expf(-g)) * up; }
                v4u w; w.x = pk2(hv[0], hv[1]); w.y = pk2(hv[2], hv[3]); w.z = pk2(hv[4], hv[5]); w.w = pk2(hv[6], hv[7]);
                *(v4u*)(H + (size_t)(row0 + ai * 128 + m * 16) * FFE + col0) = w; }
    }
};
struct EpiG2 {
    static constexpr bool PERM = true, AFTER_DRAIN = false;
    bf16* Y;
    __device__ __forceinline__ void operator()(const pg8::f32x4 (&acc)[2][2][4][2], const pg8::Unit& u, int wr, int wc, int fr, int fq) const {
        const int row0 = u.pm * 256 + wr * 64 + fr, col0 = (u.pn & 7) * 256 + wc * 32 + 8 * fq;
#pragma unroll
        for (int ai = 0; ai < 2; ++ai)
#pragma unroll
            for (int m = 0; m < 4; ++m) { bf16* rowp = Y + (size_t)(row0 + ai * 128 + m * 16) * DM + col0;
#pragma unroll
                for (int bj = 0; bj < 2; ++bj) { const f32x4 a = acc[ai][bj][m][0], b = acc[ai][bj][m][1];
                    v4u w; w.x = pk2(a.x, a.y); w.y = pk2(a.z, a.w); w.z = pk2(b.x, b.y); w.w = pk2(b.z, b.w);
                    *(v4u*)(rowp + bj * 128) = w; } }
    }
};
struct GroupedOrder {
    int nunits, nN, G, c; const int* tile_e;
    __device__ __forceinline__ bool next(int i, pg8::Unit& u) const {
        const int L = i * G + c; if (L >= nunits) return false;
        const int mt = L / nN, pl = L - mt * nN;
        u.pm = mt; u.pn = __builtin_amdgcn_readfirstlane(tile_e[mt]) * nN + pl; return true;
    }
    __device__ __forceinline__ void a_ready(const pg8::Unit&) const {}
    __device__ __forceinline__ void done(const pg8::Unit&) const {}
};

template <int R, int C, bool GATE>
__device__ __forceinline__ void row_norm_store(const LAS float* st, int pitch, const float* gain, float factor, bf16* dst, const bf16* gate) {
    constexpr int TPR = 512 / R, NK = C / (4 * TPR);
    const int tid = threadIdx.x, row = tid / TPR, part = tid % TPR;
    f32x4 v[NK]; float ss = 0.f;
#pragma unroll
    for (int k = 0; k < NK; ++k) { v[k] = *(const LAS f32x4*)(st + row * pitch + 4 * part + 4 * TPR * k); const f32x4 q = v[k] * v[k]; ss += (q.x + q.y) + (q.z + q.w); }
#pragma unroll
    for (int o = 1; o < TPR; o <<= 1) ss += __shfl_xor(ss, o);
    const float rstd = factor / sqrtf(ss * (1.0f / C) + EPS);
#pragma unroll
    for (int k = 0; k < NK; ++k) { const int col = 4 * part + 4 * TPR * k; const f32x4 g4 = *(const f32x4*)(gain + col); f32x4 o = v[k] * rstd * g4;
        if (GATE) { const v2u r2 = *(const v2u*)(gate + (size_t)row * 1024 + col); const float r0 = bflo(r2.x), r1 = bfhi(r2.x), r2f = bflo(r2.y), r3 = bfhi(r2.y);
            o.x *= r0 / (1.0f + __expf(-r0)); o.y *= r1 / (1.0f + __expf(-r1)); o.z *= r2f / (1.0f + __expf(-r2f)); o.w *= r3 / (1.0f + __expf(-r3)); }
        v2u w; w.x = pk2(o.x, o.y); w.y = pk2(o.z, o.w); *(v2u*)(dst + (size_t)row * DM + col) = w; }
}

constexpr int AT_KPITCH = 144, AT_VPITCH = 320, AT_V_OFF = 2 * 64 * 144, AT_BUF = AT_V_OFF + 64 * 320, AT_WS_OFF = 2 * AT_BUF, AT_ST_OFF = 0, AT_STP = 144;
__device__ __forceinline__ void attn_unit(const Frame& F, int b, int h, int qb, const bf16* Qp, const bf16* Kp, const bf16* Vp, bf16* MIX, float lam, float moff, const float* og) {
    const int tid = F.tid, lane = F.lane, w = F.wave, cl = lane & 31, hh = lane >> 5;
    const int map = w >> 2, rg = w & 3;
    const size_t tok0 = (size_t)b * SEQ; const int q0 = qb * 128;
    bf16x8 qf[4];
    { const bf16* qptr = Qp + (tok0 + q0 + rg * 32 + cl) * 1024 + (h * 2 + map) * 64 + 8 * hh;
#pragma unroll
      for (int ks = 0; ks < 4; ++ks) qf[ks] = *(const bf16x8*)(qptr + 16 * ks); }
    const int nt = 2 * qb + 2, mylast = 2 * qb + (rg >> 1);
    f32x16 o[4];
#pragma unroll
    for (int e = 0; e < 4; ++e)
#pragma unroll
        for (int r = 0; r < 16; ++r) o[e][r] = 0.f;
    float lsum = 0.f;
    const bf16* kg0 = Kp + (tok0 + (tid >> 3)) * 1024 + h * 128 + (tid & 7) * 8;
    const bf16* vg0 = Vp + (tok0 + (tid >> 4)) * 1024 + h * 128 + (tid & 15) * 8;
    const ldsp kdst = F.lds + (tid >> 3) * AT_KPITCH + (tid & 7) * 16;
    const ldsp vdst = F.lds + AT_V_OFF + (tid >> 4) * AT_VPITCH + (tid & 15) * 16;
    const ldsp kread = F.lds + map * (64 * AT_KPITCH) + cl * AT_KPITCH + 16 * hh;
    const ldsp vread = F.lds + AT_V_OFF + (4 * hh + ((lane & 15) >> 2)) * AT_VPITCH + (16 * ((lane >> 4) & 1) + 4 * (lane & 3)) * 2;
    v4u kr0 = *(const v4u*)kg0, kr1 = *(const v4u*)(kg0 + 64), vr0 = *(const v4u*)vg0, vr1 = *(const v4u*)(vg0 + 32 * 1024);
    *(LAS v4u*)kdst = kr0; *(LAS v4u*)(kdst + 64 * AT_KPITCH) = kr1; *(LAS v4u*)vdst = vr0; *(LAS v4u*)(vdst + 32 * AT_VPITCH) = vr1;
    { const size_t adv = (size_t)64 * 1024;
      kr0 = *(const v4u*)(kg0 + adv); kr1 = *(const v4u*)(kg0 + adv + 64); vr0 = *(const v4u*)(vg0 + adv); vr1 = *(const v4u*)(vg0 + adv + 32 * 1024); }
    __syncthreads();
    for (int t = 0; t < nt; ++t) {
        const int cb = (t & 1) * AT_BUF, nb = AT_BUF - cb;
        if (t + 1 < nt) {
            *(LAS v4u*)(kdst + nb) = kr0; *(LAS v4u*)(kdst + nb + 64 * AT_KPITCH) = kr1; *(LAS v4u*)(vdst + nb) = vr0; *(LAS v4u*)(vdst + nb + 32 * AT_VPITCH) = vr1;
            if (t + 2 < nt) { const size_t adv = (size_t)(t + 2) * 64 * 1024;
                kr0 = *(const v4u*)(kg0 + adv); kr1 = *(const v4u*)(kg0 + adv + 64); vr0 = *(const v4u*)(vg0 + adv); vr1 = *(const v4u*)(vg0 + adv + 32 * 1024); }
        }
        if (t <= mylast) {
            bf16x8 pa[4];
            {
                f32x16 s0, s1;
#pragma unroll
                for (int r = 0; r < 16; ++r) { s0[r] = -moff; s1[r] = -moff; }
                bf16x8 ka[2][4];
#pragma unroll
                for (int ks = 0; ks < 4; ++ks) { ka[0][ks] = *(const LAS bf16x8*)(kread + cb + ks * 32); ka[1][ks] = *(const LAS bf16x8*)(kread + cb + 32 * AT_KPITCH + ks * 32); }
#pragma unroll
                for (int ks = 0; ks < 4; ++ks) { s0 = MFMA32(ka[0][ks], qf[ks], s0); s1 = MFMA32(ka[1][ks], qf[ks], s1); }
#pragma unroll
                for (int r = 0; r < 16; ++r) { s0[r] = __builtin_amdgcn_exp2f(s0[r]); s1[r] = __builtin_amdgcn_exp2f(s1[r]); }
                float ls = 0.f;
#pragma unroll
                for (int r = 0; r < 16; ++r) ls += s0[r] + s1[r];
                lsum += ls;
                pa[0] = pack8(s0, 0); pa[1] = pack8(s0, 8); pa[2] = pack8(s1, 0); pa[3] = pack8(s1, 8);
            }
#pragma unroll
            for (int kst = 0; kst < 4; ++kst) {
                bf16x8 bv[4];
#pragma unroll
                for (int eb = 0; eb < 4; ++eb) { const ldsp p = vread + cb + kst * 16 * AT_VPITCH + eb * 64; bv[eb] = cat8(vtr(p), vtr(p + 8 * AT_VPITCH)); }
#pragma unroll
                for (int eb = 0; eb < 4; ++eb) o[eb] = MFMA32(pa[kst], bv[eb], o[eb]);
            }
        }
        __syncthreads();
    }
    lsum += __shfl_xor(lsum, 32);
    const float inv = (map == 0 ? 1.0f : lam) / lsum;
    LAS float* wsf = (LAS float*)(F.lds + AT_WS_OFF) + w * 32;
    if (hh == 0) wsf[cl] = inv;
    LDS_WAIT();
    float rinv[16];
#pragma unroll
    for (int r = 0; r < 16; ++r) rinv[r] = wsf[crow(r, hh)];
    LAS float* st = (LAS float*)(F.lds + AT_ST_OFF);
    if (map == 1) {
#pragma unroll
        for (int eb = 0; eb < 4; ++eb)
#pragma unroll
            for (int r = 0; r < 16; ++r) st[(rg * 32 + crow(r, hh)) * AT_STP + eb * 32 + cl] = o[eb][r] * rinv[r];
    }
    __syncthreads();
    if (map == 0) {
#pragma unroll
        for (int eb = 0; eb < 4; ++eb)
#pragma unroll
            for (int r = 0; r < 16; ++r) { const int ix = (rg * 32 + crow(r, hh)) * AT_STP + eb * 32 + cl; st[ix] = o[eb][r] * rinv[r] - st[ix]; }
    }
    __syncthreads();
    row_norm_store<128, 128, false>(st, AT_STP, og, 1.0f - LAMBDA_INIT, MIX + (tok0 + q0) * DM + h * 128, nullptr);
    __syncthreads();
}

constexpr int GL_GA = 0, GL_BC = 4096, GL_PART = GL_BC + 32768;
__device__ __forceinline__ void gla_bcum(const Frame& F, size_t tok0, int h, const float* GA, const float* W2, const float* B2) {
    const int tid = F.tid;
    LAS float* gas = (LAS float*)(F.lds + GL_GA); LAS float* bc = (LAS float*)(F.lds + GL_BC); LAS float* part = (LAS float*)(F.lds + GL_PART);
    if (tid < 256) *(LAS f32x4*)(gas + tid * 4) = *(const f32x4*)(GA + tok0 * 16 + tid * 4);
    const int d = tid & 127, qtr = tid >> 7;
    float w2[16];
#pragma unroll
    for (int r = 0; r < 16; ++r) w2[r] = W2[r * 512 + h * 128 + d];
    const float bb = B2[h * 128 + d];
    __syncthreads();
    float run = 0.f;
#pragma unroll
    for (int i = 0; i < 16; ++i) { const int l = qtr * 16 + i; float pre = bb;
#pragma unroll
        for (int r4 = 0; r4 < 4; ++r4) { const f32x4 g4 = *(const LAS f32x4*)(gas + l * 16 + r4 * 4); pre += g4.x * w2[r4 * 4] + g4.y * w2[r4 * 4 + 1] + g4.z * w2[r4 * 4 + 2] + g4.w * w2[r4 * 4 + 3]; }
        const float ls = fminf(pre, 0.f) - __logf(1.0f + __expf(-fabsf(pre)));
        run += ls * (1.0f / 16.0f); bc[l * 128 + d] = run; }
    part[qtr * 128 + d] = run;
    __syncthreads();
    float off = 0.f;
    if (qtr > 0) off += part[d];
    if (qtr > 1) off += part[128 + d];
    if (qtr > 2) off += part[256 + d];
#pragma unroll
    for (int i = 0; i < 16; ++i) bc[(qtr * 16 + i) * 128 + d] += off;
    __syncthreads();
}
constexpr int GA_KD = GL_PART + 2048, GA_KDP = 320, GA_V = GA_KD + 64 * GA_KDP, GA_VP = 576;
__device__ __forceinline__ void gla_a_unit(const Frame& F, int bh, int c, const bf16* GK, const bf16* GV, const float* GA, const float* W2, const float* B2, bf16* U, float* DEC) {
    const int tid = F.tid, lane = F.lane, w = F.wave, cl = lane & 31, hh = lane >> 5;
    const int b = bh >> 2, h = bh & 3; const size_t tok0 = (size_t)b * SEQ + c * 64;
    v4u kr[2], vr[4];
#pragma unroll
    for (int i = 0; i < 2; ++i) { const int p = tid + 512 * i, l = p >> 4, ch = p & 15; kr[i] = *(const v4u*)(GK + (tok0 + l) * 512 + h * 128 + ch * 8); }
#pragma unroll
    for (int i = 0; i < 4; ++i) { const int p = tid + 512 * i, l = p >> 5, ch = p & 31; vr[i] = *(const v4u*)(GV + (tok0 + l) * 1024 + h * 256 + ch * 8); }
    gla_bcum(F, tok0, h, GA, W2, B2);
    const LAS float* bc = (const LAS float*)(F.lds + GL_BC);
#pragma unroll
    for (int i = 0; i < 4; ++i) { const int p = tid + 512 * i, l = p >> 5, ch = p & 31; *(LAS v4u*)(F.lds + GA_V + l * GA_VP + ch * 16) = vr[i]; }
#pragma unroll
    for (int i = 0; i < 2; ++i) { const int p = tid + 512 * i, l = p >> 4, ch = p & 15;
        const f32x4 la = *(const LAS f32x4*)(bc + 63 * 128 + ch * 8), lb = *(const LAS f32x4*)(bc + 63 * 128 + ch * 8 + 4);
        const f32x4 ba = *(const LAS f32x4*)(bc + l * 128 + ch * 8), bb = *(const LAS f32x4*)(bc + l * 128 + ch * 8 + 4);
        const v4u k = kr[i]; v4u o;
        o.x = pk2(bflo(k.x) * __expf(la.x - ba.x), bfhi(k.x) * __expf(la.y - ba.y)); o.y = pk2(bflo(k.y) * __expf(la.z - ba.z), bfhi(k.y) * __expf(la.w - ba.w));
        o.z = pk2(bflo(k.z) * __expf(lb.x - bb.x), bfhi(k.z) * __expf(lb.y - bb.y)); o.w = pk2(bflo(k.w) * __expf(lb.z - bb.z), bfhi(k.w) * __expf(lb.w - bb.w));
        *(LAS v4u*)(F.lds + GA_KD + l * GA_KDP + ch * 16) = o; }
    if (tid < 128) DEC[(size_t)(bh * 32 + c) * 128 + tid] = __expf(bc[63 * 128 + tid]);
    __syncthreads();
    f32x16 acc[4];
#pragma unroll
    for (int nb = 0; nb < 4; ++nb)
#pragma unroll
        for (int r = 0; r < 16; ++r) acc[nb][r] = 0.f;
    const int trow = 4 * hh + ((lane & 15) >> 2), tcol = (16 * ((lane >> 4) & 1) + 4 * (lane & 3)) * 2;
    const ldsp vrd = F.lds + GA_V + trow * GA_VP + 64 * w + tcol;
    const ldsp krd = F.lds + GA_KD + trow * GA_KDP + tcol;
#pragma unroll
    for (int ks = 0; ks < 4; ++ks) { const bf16x8 a = cat8(vtr(vrd + ks * 16 * GA_VP), vtr(vrd + ks * 16 * GA_VP + 8 * GA_VP));
#pragma unroll
        for (int nb = 0; nb < 4; ++nb) { const bf16x8 bb = cat8(vtr(krd + ks * 16 * GA_KDP + nb * 64), vtr(krd + ks * 16 * GA_KDP + 8 * GA_KDP + nb * 64)); acc[nb] = MFMA32(a, bb, acc[nb]); } }
    bf16* up = U + ((size_t)(bh * 32 + c) * 256 + 32 * w) * 128 + cl;
#pragma unroll
    for (int nb = 0; nb < 4; ++nb)
#pragma unroll
        for (int r = 0; r < 16; ++r) up[(size_t)crow(r, hh) * 128 + 32 * nb] = (bf16)f2bf(acc[nb][r]);
    __syncthreads();
}
__device__ __forceinline__ void gla_scan(const Frame& F, const bf16* U, const float* DEC, bf16* ST) {
    for (int q = blockIdx.x * 512 + F.tid; q < 16 * 8192; q += F.G * 512) {
        const int bh = q >> 13, rem = q & 8191, d4 = (rem & 31) * 4;
        f32x4 s = (f32x4){0.f, 0.f, 0.f, 0.f};
        const size_t base = (size_t)bh * 32 * 32768 + (size_t)rem * 4;
#pragma unroll 4
        for (int c = 0; c < 32; ++c) {
            const v2u ub = *(const v2u*)(U + base + (size_t)c * 32768); const f32x4 u4 = (f32x4){bflo(ub.x), bfhi(ub.x), bflo(ub.y), bfhi(ub.y)}; const f32x4 dc = *(const f32x4*)(DEC + (size_t)(bh * 32 + c) * 128 + d4);
            v2u o; o.x = pk2(s.x, s.y); o.y = pk2(s.z, s.w); *(v2u*)(ST + base + (size_t)c * 32768) = o;
            s = s * dc + u4;
        }
    }
}
constexpr int GC_QI = GL_PART + 2048, GC_KI = GC_QI + 64 * 272, GC_V = GC_KI + 64 * 272, GC_VP = 576, GC_STP = 288;
__device__ __forceinline__ void gla_c_unit(const Frame& F, int bh, int c, const bf16* GQ, const bf16* GK, const bf16* GV, const bf16* GR, const float* GA, const float* W2, const float* B2, const bf16* ST, const float* og, bf16* MIX) {
    const int tid = F.tid, lane = F.lane, w = F.wave, cl = lane & 31, hh = lane >> 5;
    const int b = bh >> 2, h = bh & 3; const size_t tok0 = (size_t)b * SEQ + c * 64;
    const int ib = w & 1, eq = w >> 1;
    v4u qr[2], kr[2], vr[4]; bf16x8 bs[2][8];
#pragma unroll
    for (int i = 0; i < 2; ++i) { const int p = tid + 512 * i, l = p >> 4, ch = p & 15; qr[i] = *(const v4u*)(GQ + (tok0 + l) * 512 + h * 128 + ch * 8); kr[i] = *(const v4u*)(GK + (tok0 + l) * 512 + h * 128 + ch * 8); }
#pragma unroll
    for (int i = 0; i < 4; ++i) { const int p = tid + 512 * i, l = p >> 5, ch = p & 31; vr[i] = *(const v4u*)(GV + (tok0 + l) * 1024 + h * 256 + ch * 8); }
    { const bf16* stp = ST + ((size_t)(bh * 32 + c) * 256 + eq * 64 + cl) * 128 + 8 * hh;
#pragma unroll
      for (int e2 = 0; e2 < 2; ++e2)
#pragma unroll
          for (int ks = 0; ks < 8; ++ks) bs[e2][ks] = *(const bf16x8*)(stp + (size_t)e2 * 32 * 128 + 16 * ks); }
    gla_bcum(F, tok0, h, GA, W2, B2);
    const LAS float* bc = (const LAS float*)(F.lds + GL_BC);
    LAS bf16* qi = (LAS bf16*)(F.lds + GC_QI); LAS bf16* ki = (LAS bf16*)(F.lds + GC_KI);
#pragma unroll
    for (int i = 0; i < 2; ++i) { const int p = tid + 512 * i, l = p >> 4, ch = p & 15;
        const f32x4 ba = *(const LAS f32x4*)(bc + l * 128 + ch * 8), bb = *(const LAS f32x4*)(bc + l * 128 + ch * 8 + 4);
        const f32x4 ea = (f32x4){__expf(ba.x), __expf(ba.y), __expf(ba.z), __expf(ba.w)}, eb = (f32x4){__expf(bb.x), __expf(bb.y), __expf(bb.z), __expf(bb.w)};
        const v4u q = qr[i], k = kr[i]; v4u oq, ok;
        oq.x = pk2(bflo(q.x) * QSCALE_GLA * ea.x, bfhi(q.x) * QSCALE_GLA * ea.y); oq.y = pk2(bflo(q.y) * QSCALE_GLA * ea.z, bfhi(q.y) * QSCALE_GLA * ea.w);
        oq.z = pk2(bflo(q.z) * QSCALE_GLA * eb.x, bfhi(q.z) * QSCALE_GLA * eb.y); oq.w = pk2(bflo(q.w) * QSCALE_GLA * eb.z, bfhi(q.w) * QSCALE_GLA * eb.w);
        ok.x = pk2(bflo(k.x) / ea.x, bfhi(k.x) / ea.y); ok.y = pk2(bflo(k.y) / ea.z, bfhi(k.y) / ea.w);
        ok.z = pk2(bflo(k.z) / eb.x, bfhi(k.z) / eb.y); ok.w = pk2(bflo(k.w) / eb.z, bfhi(k.w) / eb.w);
        *(LAS v4u*)(qi + l * 136 + ch * 8) = oq; *(LAS v4u*)(ki + l * 136 + ch * 8) = ok; }
#pragma unroll
    for (int i = 0; i < 4; ++i) { const int p = tid + 512 * i, l = p >> 5, ch = p & 31; *(LAS v4u*)(F.lds + GC_V + l * GC_VP + ch * 16) = vr[i]; }
    __syncthreads();
    bf16x8 pa[4];
#pragma unroll
    for (int jb = 0; jb < 2; ++jb) {
        if (jb <= ib) {
            f32x16 s;
#pragma unroll
            for (int r = 0; r < 16; ++r) s[r] = 0.f;
#pragma unroll
            for (int ks = 0; ks < 8; ++ks) { const bf16x8 a = *(const LAS bf16x8*)(ki + (32 * jb + cl) * 136 + 16 * ks + 8 * hh); const bf16x8 bq = *(const LAS bf16x8*)(qi + (32 * ib + cl) * 136 + 16 * ks + 8 * hh); s = MFMA32(a, bq, s); }
#pragma unroll
            for (int r = 0; r < 16; ++r) { const int j = 32 * jb + crow(r, hh), i = 32 * ib + cl; if (j > i) s[r] = 0.f; }
            pa[jb * 2] = pack8(s, 0); pa[jb * 2 + 1] = pack8(s, 8);
        } else { pa[jb * 2] = (bf16x8){0, 0, 0, 0, 0, 0, 0, 0}; pa[jb * 2 + 1] = (bf16x8){0, 0, 0, 0, 0, 0, 0, 0}; }
    }
    f32x16 o[2];
#pragma unroll
    for (int e2 = 0; e2 < 2; ++e2)
#pragma unroll
        for (int r = 0; r < 16; ++r) o[e2][r] = 0.f;
    const ldsp vread = F.lds + GC_V + (4 * hh + ((lane & 15) >> 2)) * GC_VP + (16 * ((lane >> 4) & 1) + 4 * (lane & 3)) * 2;
#pragma unroll
    for (int e2 = 0; e2 < 2; ++e2)
#pragma unroll
        for (int kst = 0; kst < 4; ++kst) {
            if (kst < 2 * (ib + 1)) { const ldsp p = vread + kst * 16 * GC_VP + (eq * 2 + e2) * 64; const bf16x8 bv = cat8(vtr(p), vtr(p + 8 * GC_VP)); o[e2] = MFMA32(pa[kst], bv, o[e2]); }
        }
#pragma unroll
    for (int ks = 0; ks < 8; ++ks) { const bf16x8 a = *(const LAS bf16x8*)(qi + (32 * ib + cl) * 136 + 16 * ks + 8 * hh);
#pragma unroll
        for (int e2 = 0; e2 < 2; ++e2) o[e2] = MFMA32(a, bs[e2][ks], o[e2]); }
    __syncthreads();
    LAS float* st = (LAS float*)F.lds;
#pragma unroll
    for (int e2 = 0; e2 < 2; ++e2)
#pragma unroll
        for (int r = 0; r < 16; ++r) st[(32 * ib + crow(r, hh)) * GC_STP + eq * 64 + e2 * 32 + cl] = o[e2][r];
    __syncthreads();
    row_norm_store<64, 256, true>(st, GC_STP, og, 1.0f, MIX + tok0 * DM + 1024 + h * 256, GR + tok0 * 1024 + h * 256);
    __syncthreads();
}

__device__ __forceinline__ void router_phase(const Frame& F, const Args& A, const int dummy) {
    unsigned char* ws = A.ws;
    const float* x2 = A.out; const float* g2 = A.in[15]; const float* wrg = A.in[16]; const float* brg = A.in[17]; const float* wre = A.in[18]; const float* bre = A.in[19];
    bf16* XN = (bf16*)(ws + WS_XN); unsigned* wcnt = (unsigned*)(ws + WS_WCNT + (dummy ? 32768 : 0));
    LAS unsigned* lcnt = (LAS unsigned*)(F.lds + 81920 + 8 * 144 * 4);
    if (!dummy) { const int g = blockIdx.x * 512 + F.tid; if (g < MAXROWS) { ((int*)(ws + WS_ROWTOK))[g] = 0; ((float*)(ws + WS_RS))[g] = 0.f; } }
    if (F.tid < NEXP) lcnt[F.tid] = 0u;
    int* toke = (int*)(ws + WS_TOKE + (dummy ? WS_U - WS_TOKE : 0)); int* tokr = (int*)(ws + WS_TOKR + (dummy ? WS_U - WS_TOKE : 0)); float* tokw = (float*)(ws + WS_TOKW + (dummy ? WS_U - WS_TOKE : 0)); float* toks = (float*)(ws + WS_TOKS + (dummy ? WS_U - WS_TOKE : 0));
    LAS float* wq = (LAS float*)F.lds;
    const float* WR = (const float*)(ws + WS_WR);
    LAS float* lgs = (LAS float*)(F.lds + 81920);
    const int lane = F.lane;
    for (int base = 0; base < T / 4; base += F.G * NWAVES) {
        const int rg = base + blockIdx.x * NWAVES + F.wave; const bool act = rg < T / 4; const int rgc = act ? rg : 0;
        float myss = 0.f;
        f32x4 xnx[2][2];
#pragma unroll
        for (int i = 0; i < 2; ++i)
#pragma unroll
            for (int rr = 0; rr < 2; ++rr) xnx[rr][i] = *(const f32x4*)(x2 + (size_t)(rgc * 4 + rr) * DM + 4 * lane + 256 * i);
#pragma unroll 1
        for (int hf = 0; hf < 2; ++hf) {
            float ssq[2];
            f32x2 acc[2][18];
#pragma unroll
            for (int rr = 0; rr < 2; ++rr) { ssq[rr] = 0.f;
#pragma unroll
                for (int j = 0; j < 18; ++j) acc[rr][j] = (f32x2){0.f, 0.f}; }
#pragma unroll 1
            for (int q = 0; q < 4; ++q) {
                f32x4 xr[2][2];
#pragma unroll
                for (int i = 0; i < 2; ++i)
#pragma unroll
                    for (int rr = 0; rr < 2; ++rr) xr[rr][i] = xnx[rr][i];
                { const int sn = hf * 4 + q + 1, hfn = sn >> 2, qn = sn & 3;
                  if (sn < 8) {
#pragma unroll
                      for (int i = 0; i < 2; ++i)
#pragma unroll
                          for (int rr = 0; rr < 2; ++rr) xnx[rr][i] = *(const f32x4*)(x2 + (size_t)(rgc * 4 + hfn * 2 + rr) * DM + qn * 512 + 4 * lane + 256 * i); } }
#pragma unroll
                for (int i = 0; i < 2; ++i) { const f32x4 g4 = *(const f32x4*)(g2 + q * 512 + 4 * lane + 256 * i);
#pragma unroll
                    for (int rr = 0; rr < 2; ++rr) { const size_t o = (size_t)(rgc * 4 + hf * 2 + rr) * DM + q * 512 + 4 * lane + 256 * i;
                        const f32x4 sq = xr[rr][i] * xr[rr][i]; ssq[rr] += (sq.x + sq.y) + (sq.z + sq.w);
                        const f32x4 y = xr[rr][i] * g4; v2u w; w.x = pk2(y.x, y.y); w.y = pk2(y.z, y.w); if (act) *(v2u*)(XN + o) = w; } }
                __syncthreads();
                { const v4u* src = (const v4u*)(WR + (size_t)q * 512 * 36);
#pragma unroll
                  for (int u = 0; u < 9; ++u) ((LAS v4u*)wq)[F.tid + 512 * u] = src[F.tid + 512 * u]; }
                __syncthreads();
#pragma unroll
                for (int i = 0; i < 2; ++i) {
#pragma unroll
                    for (int c = 0; c < 4; ++c) {
                        const LAS float* wrow = wq + ((i * 4 + c) * 64 + lane) * 36;
                        f32x2 wv[18];
#pragma unroll
                        for (int jj = 0; jj < 9; ++jj) { const f32x4 t4 = *(const LAS f32x4*)(wrow + 4 * jj); wv[2 * jj] = (f32x2){t4.x, t4.y}; wv[2 * jj + 1] = (f32x2){t4.z, t4.w}; }
#pragma unroll
                        for (int rr = 0; rr < 2; ++rr) { const float xs = xr[rr][i][c]; const f32x2 x2v = (f32x2){xs, xs};
#pragma unroll
                            for (int j = 0; j < 18; ++j) acc[rr][j] = __builtin_elementwise_fma(x2v, wv[j], acc[rr][j]); }
                    }
                }
            }
            {
                float v[64];
#define RSTEP(M) { const bool up = (lane & (M)) != 0; _Pragma("unroll") for (int i = 0; i < (M); ++i) { const float send = up ? v[i] : v[i + (M)]; const float keep = up ? v[i + (M)] : v[i]; v[i] = keep + __shfl_xor(send, (M)); } }
#define ACCF(f) acc[(f) / 36][((f) % 36) >> 1][(f) & 1]
#pragma unroll
                for (int f = 0; f < 64; ++f) v[f] = ACCF(f);
                RSTEP(32) RSTEP(16) RSTEP(8) RSTEP(4) RSTEP(2) RSTEP(1)
                lgs[F.wave * 144 + hf * 72 + lane] = v[0];
#pragma unroll
                for (int f = 0; f < 8; ++f) v[f] = ACCF(64 + f);
                RSTEP(4) RSTEP(2) RSTEP(1)
                v[0] += __shfl_xor(v[0], 8); v[0] += __shfl_xor(v[0], 16); v[0] += __shfl_xor(v[0], 32);
                if (lane < 8) lgs[F.wave * 144 + hf * 72 + 64 + lane] = v[0];
#undef RSTEP
#undef ACCF
            }
#pragma unroll
            for (int rr = 0; rr < 2; ++rr) { ssq[rr] = wave_sum(ssq[rr]); if (lane == hf * 2 + rr) myss = ssq[rr]; }
        }
        LDS_WAIT();
        float my[36];
#pragma unroll
        for (int j = 0; j < 36; ++j) my[j] = lgs[F.wave * 144 + (lane & 3) * 36 + j];
        if (act && lane < 4) {
            const int t = rg * 4 + lane;
            const float rstd = 1.0f / sqrtf(myss * (1.0f / DM) + EPS);
            float lg[4]; int gs = 0; float mx = -INFINITY;
#pragma unroll
            for (int g = 0; g < 4; ++g) { lg[g] = my[g] * rstd + brg[g]; if (lg[g] > mx) { mx = lg[g]; gs = g; } }
            float sum = 0.f;
#pragma unroll
            for (int g = 0; g < 4; ++g) sum += __expf(lg[g] - mx);
            const float pgsel = 1.0f / sum;
            float le[8];
#pragma unroll
            for (int e = 0; e < 8; ++e) { const float v = (gs == 0) ? my[4 + e] : (gs == 1) ? my[12 + e] : (gs == 2) ? my[20 + e] : my[28 + e]; le[e] = v * rstd + bre[gs * 8 + e]; }
            int ia = 0; float ma = -INFINITY;
#pragma unroll
            for (int e = 0; e < 8; ++e) if (le[e] > ma) { ma = le[e]; ia = e; }
            int ib = 0; float mb = -INFINITY;
#pragma unroll
            for (int e = 0; e < 8; ++e) if (e != ia && le[e] > mb) { mb = le[e]; ib = e; }
            const float eb = __expf(mb - ma); const float wa = pgsel / (1.0f + eb), wb = pgsel * eb / (1.0f + eb);
            const int ea = gs * 8 + ia, ebx = gs * 8 + ib;
            const unsigned ra = __hip_atomic_fetch_add(lcnt + ea, 1u, __ATOMIC_RELAXED, __HIP_MEMORY_SCOPE_WORKGROUP);
            const unsigned rb = __hip_atomic_fetch_add(lcnt + ebx, 1u, __ATOMIC_RELAXED, __HIP_MEMORY_SCOPE_WORKGROUP);
            toke[t * 2] = ea; toke[t * 2 + 1] = ebx; tokr[t * 2] = (int)ra; tokr[t * 2 + 1] = (int)rb; tokw[t * 2] = wa; tokw[t * 2 + 1] = wb; toks[t] = rstd;
        }
    }
    __syncthreads();
    if (F.tid < NEXP) wcnt[blockIdx.x * NEXP + F.tid] = lcnt[F.tid];
}
__device__ __forceinline__ void moe_offsets(const Frame& F, LAS int* toff, LAS int* basel, const unsigned* wcnt) {
    LAS int* psum = (LAS int*)F.lds; LAS int* pcap = psum + 512; LAS int* cntl = pcap + 512;
    const int e = F.tid & 31, p = F.tid >> 5, b = blockIdx.x;
    int sacc = 0, cap = 0;
#pragma unroll
    for (int i = 0; i < 16; ++i) { const int row = p * 16 + i; const int v = (int)wcnt[row * NEXP + e]; if (row == b) cap = sacc; sacc += v; }
    psum[p * 32 + e] = sacc; pcap[p * 32 + e] = cap;
    __syncthreads();
    if (F.tid < NEXP) { int total = 0, base = 0;
        for (int q = 0; q < 16; ++q) { if (q == (b >> 4)) base = total + pcap[q * 32 + e]; total += psum[q * 32 + e]; }
        cntl[e] = total; basel[e] = base; }
    __syncthreads();
    if (F.tid == 0) { int a = 0;
        for (int q = 0; q < NEXP; ++q) { toff[q] = a; a += (cntl[q] + 255) >> 8; }
        toff[NEXP] = a; }
    __syncthreads();
}

constexpr int LDS_BYTES = 147456;
constexpr int RING_BYTES = 131072;
constexpr int MISC_OFF = LDS_BYTES - 4096;

__global__ void __launch_bounds__(NWAVES * 64, 2) fwd(Args args) {
    extern __shared__ __attribute__((aligned(16))) unsigned char lds_raw[];
    Frame F;
    F.lds = (ldsp)lds_raw;
    F.tid = threadIdx.x; F.lane = F.tid & 63; F.wave = __builtin_amdgcn_readfirstlane(F.tid >> 6);
    F.G = gridDim.x; { const int bx = blockIdx.x; F.vcu = (F.G % 8 == 0) ? (bx % 8) * (F.G / 8) + bx / 8 : bx; }
    volatile LAS unsigned* MISC = (volatile LAS unsigned*)(F.lds + MISC_OFF);
    LAS int* toff = (LAS int*)(F.lds + MISC_OFF + 512); LAS int* basel = toff + 64;
    LAS float* lamv = (LAS float*)(F.lds + MISC_OFF + 1024);
    unsigned char* ws = args.ws;
    unsigned* ctl = (unsigned*)(ws + WS_CTL);
    for (int u = F.tid; u < (LDS_BYTES - RING_BYTES) / 4; u += NWAVES * 64) ((LAS unsigned*)(F.lds + RING_BYTES))[u] = 0u;
    __syncthreads();
    const int lo = args.ph_lo, hi = args.ph_hi;
    XcdBarrier bar; bar.bar = ctl + CW_BAR; bar.x = 0; bar.st = nullptr;
    if (hi - lo > 1) bar = xcd_barrier_post(ctl + CW_BAR, MISC + 8);
#ifndef PH_MASK
#define PH_MASK 0x7ff
#endif
#define IN(k) (((PH_MASK >> (k)) & 1) && lo <= (k) && (k) < hi)
#ifndef REP_MASK
#define REP_MASK 0
#endif
#define REP(k) _Pragma("unroll 1") for (int rep_ = 0; rep_ <= ((REP_MASK >> (k)) & 1); ++rep_)
#ifdef PROBE_BAR
#define SEAM(k) do { if (IN(k) && IN((k) + 1)) { xcd_barrier(bar); xcd_barrier(bar); } } while (0)
#else
#define SEAM(k) do { if (IN(k) && IN((k) + 1)) xcd_barrier(bar); } while (0)
#endif

    bf16* WinT = (bf16*)(ws + WS_WIN_T); bf16* WoutT = (bf16*)(ws + WS_WOUT_T); bf16* WguT = (bf16*)(ws + WS_WGU_T); bf16* WdT = (bf16*)(ws + WS_WD_T);
    bf16* XN = (bf16*)(ws + WS_XN); bf16* PROJ = (bf16*)(ws + WS_PROJ); bf16* MIX = (bf16*)(ws + WS_MIX); bf16* HB = (bf16*)(ws + WS_H);
    bf16* YB = PROJ;
    bf16* U = (bf16*)(ws + WS_U); bf16* ST = (bf16*)(ws + WS_ST); float* GA = (float*)(ws + WS_GA); float* CS = (float*)(ws + WS_CS); float* DEC = (float*)(ws + WS_DEC);
    int* toke = (int*)(ws + WS_TOKE); int* tokr = (int*)(ws + WS_TOKR); float* tokw = (float*)(ws + WS_TOKW); int* tile = (int*)(ws + WS_TILE); int* tokp = (int*)(ws + WS_TOKP); float* toks = (float*)(ws + WS_TOKS); float* RS = (float*)(ws + WS_RS); int* rowtok = (int*)(ws + WS_ROWTOK);
    const bf16* Qp = PROJ; const bf16* Kp = PROJ + (size_t)T * 1024; const bf16* Vp = PROJ + (size_t)2 * T * 1024;
    const bf16* GQ = PROJ + (size_t)3 * T * 1024; const bf16* GK = GQ + (size_t)T * 512; const bf16* GV = PROJ + (size_t)4 * T * 1024; const bf16* GR = PROJ + (size_t)5 * T * 1024;

    if (IN(0)) { p0_prologue(F, args); }
    SEAM(0);
    if (IN(1)) {
        const bool split = (F.G == 256); const int GG = split ? 192 : F.G;
        if ((int)blockIdx.x < GG) {
            pg8::Gemm g{XN, WinT, T, NPROJ, DM}; pg8::StaticOrder S; S.init(T, NPROJ, GG, (int)blockIdx.x);
            EpiProj E{PROJ, CS, args.in[4], args.in[5]};
            pg8::gemm_phase<EpiProj, pg8::StaticOrder, true, true>(F.lds, g, S, E);
        }
        if (!split || (int)blockIdx.x >= GG) {
            LAS float* scr = (LAS float*)(F.lds + F.wave * 16640);
            const int cw = split ? ((int)blockIdx.x - GG) * NWAVES + F.wave : F.vcu * NWAVES + F.wave, ncw = split ? (F.G - GG) * NWAVES : F.G * NWAVES;
            if (!split) __syncthreads();
#define DESC_GU(i) tr_desc_gateup((i), args.in[20], args.in[21], WguT)
            TR_STREAM(DESC_GU, cw, ncw, I_GATEUP, scr, F.lane);
#ifdef PROBE_CONV2
            TR_STREAM(DESC_GU, cw, ncw, I_GATEUP, scr, F.lane);
#endif
#undef DESC_GU
        }
    }
    SEAM(1);
    if (IN(2)) {
        if (F.wave == 0) {
            const float a = wave_sum(args.in[6][F.lane] * args.in[7][F.lane]), b2 = wave_sum(args.in[8][F.lane] * args.in[9][F.lane]);
            float mq = fabsf(args.in[4][F.lane]), mk = fabsf(args.in[5][F.lane]);
#pragma unroll
            for (int o = 1; o < 64; o <<= 1) { mq = fmaxf(mq, __shfl_xor(mq, o)); mk = fmaxf(mk, __shfl_xor(mk, o)); }
            if (F.lane == 0) { lamv[0] = __expf(a) - __expf(b2) + LAMBDA_INIT; lamv[1] = 8.0f * mq * mk * 1.4426950408889634f; }
        }
        __syncthreads();
        const float lam = lamv[0], moff = lamv[1];
        for (int v = F.vcu; v < 256; v += F.G) {
            const int bh = v >> 3, s = v & 7;
#ifdef PROBE_ATT
#define ATT_PASSES 4
#else
#define ATT_PASSES 2
#endif
#pragma unroll 1
            for (int pass = 0; pass < ATT_PASSES; ++pass) attn_unit(F, bh >> 3, bh & 7, (pass & 1) ? 15 - s : s, Qp, Kp, Vp, MIX, lam, moff, args.in[10]);
        }
        for (int un = F.vcu; un < 512; un += F.G) gla_a_unit(F, un >> 5, un & 31, GK, GV, GA, args.in[11], args.in[12], U, DEC);
#ifdef PROBE_GLAA
        for (int un = F.vcu; un < 512; un += F.G) gla_a_unit(F, un >> 5, un & 31, GK, GV, GA, args.in[11], args.in[12], U, DEC);
#endif
    }
    SEAM(2);
    if (IN(3)) { gla_scan(F, U, DEC, ST); }
    SEAM(3);
    if (IN(4)) {
        for (int un = F.vcu; un < 512; un += F.G) gla_c_unit(F, un >> 5, un & 31, GQ, GK, GV, GR, GA, args.in[11], args.in[12], ST, args.in[13], MIX);
    }
    SEAM(4);
    if (IN(5)) {
        pg8::Gemm g{MIX, WoutT, T, DM, DM}; pg8::StaticOrder S; S.init(T, DM, F.G, (int)blockIdx.x);
        EpiOut E{args.in[0], args.out};
        pg8::gemm_phase<EpiOut, pg8::StaticOrder, false, true>(F.lds, g, S, E);
    }
    SEAM(5);
#ifdef PROBE_P6
    if (IN(6)) { router_phase(F, args, 1); __syncthreads(); }
#endif
    if (IN(6)) { router_phase(F, args, 0); }
    SEAM(6);
    if (IN(7)) {
        moe_offsets(F, toff, basel, (const unsigned*)(ws + WS_WCNT));
        if (blockIdx.x == 0 && F.tid < NEXP) { const int e = F.tid; for (int i = toff[e]; i < toff[e + 1]; ++i) tile[i] = e; if (e == 0) tile[100] = toff[NEXP]; }
#pragma unroll 1
        for (int i = 0; i < 8; ++i) {
            const int pi = blockIdx.x * 64 + F.wave * 8 + i, t = pi >> 1, e = toke[pi]; const int pos = toff[e] * 256 + basel[e] + tokr[pi];
            if (F.lane == 0) { tokp[pi] = pos; RS[pos] = toks[t]; rowtok[pos] = t; }
        }
    }
    SEAM(7);
    if (IN(8)) {
        const int ntile = __builtin_amdgcn_readfirstlane(tile[100]);
        pg8::Gemm g{XN, WguT, 0, 0, DM}; GroupedOrder S{ntile * 4, 4, F.G, (int)blockIdx.x, tile};
        EpiG1 E{HB, RS};
        pg8::gemm_phase_ga<EpiG1, GroupedOrder, true, true>(F.lds, g, rowtok, S, E);
        {
            const int nunits = ntile * 4, R = (nunits + F.G - 1) / F.G, c0 = nunits - F.G * (R - 1);
            int nl = F.G - c0; const int c = (int)blockIdx.x; int li = c - c0;
            if (nl <= 0) { nl = F.G; li = c; }
            int q = (I_DOWN + nl - 1) / nl; if (q > 96) q = 96;
            const int nA = (nl * q < I_DOWN) ? nl * q : I_DOWN;
            LAS float* scr = (LAS float*)(F.lds + F.wave * 16640);
#define DESC_DN(i) tr_desc_down((i), args.in[22], WdT)
            if (li >= 0) { const int lim = (li * q + q < nA) ? li * q + q : nA; TR_STREAM(DESC_DN, li * q + F.wave, NWAVES, lim, scr, F.lane); }
            TR_STREAM(DESC_DN, nA + F.vcu * NWAVES + F.wave, F.G * NWAVES, I_DOWN, scr, F.lane);
#undef DESC_DN
        }
    }
    SEAM(8);
    if (IN(9)) {
        const int ntile = __builtin_amdgcn_readfirstlane(tile[100]);
        pg8::Gemm g{HB, WdT, 0, 0, FFE}; GroupedOrder S{ntile * 8, 8, F.G, (int)blockIdx.x, tile};
        EpiG2 E{YB};
        pg8::gemm_phase<EpiG2, GroupedOrder, true, true>(F.lds, g, S, E);
    }
    SEAM(9);
#ifdef PROBE_P10
    if (IN(10)) {
        const int gw = F.vcu * NWAVES + F.wave, NGW = F.G * NWAVES;
        for (int t = gw; t < T; t += NGW) {
            const size_t pa = (size_t)tokp[2 * t], pb = (size_t)tokp[2 * t + 1];
            const float wa = tokw[2 * t], wb = tokw[2 * t + 1];
            const float* orow = args.out + (size_t)t * DM; float* drow = (float*)(ws + WS_U) + (size_t)t * DM; const bf16* ya = YB + pa * DM; const bf16* yb = YB + pb * DM;
#pragma unroll
            for (int j = 0; j < 8; ++j) { const int col = 4 * F.lane + 256 * j; f32x4 v = *(const f32x4*)(orow + col);
                const v2u a = *(const v2u*)(ya + col), b = *(const v2u*)(yb + col);
                v.x += wa * bflo(a.x) + wb * bflo(b.x); v.y += wa * bfhi(a.x) + wb * bfhi(b.x); v.z += wa * bflo(a.y) + wb * bflo(b.y); v.w += wa * bfhi(a.y) + wb * bfhi(b.y);
                *(f32x4*)(drow + col) = v; }
        }
    }
    __syncthreads();
#endif
    if (IN(10)) {
        const int gw = F.vcu * NWAVES + F.wave, NGW = F.G * NWAVES;
        for (int t0 = gw; t0 < T; t0 += 4 * NGW) {
            int pa[4], pb[4]; float wa[4], wb[4];
#pragma unroll
            for (int k = 0; k < 4; ++k) { const int t = t0 + k * NGW; const bool ok = t < T; const int tc = ok ? t : 0; pa[k] = tokp[2 * tc]; pb[k] = tokp[2 * tc + 1]; wa[k] = tokw[2 * tc]; wb[k] = tokw[2 * tc + 1]; }
#pragma unroll
            for (int k = 0; k < 4; ++k) { const int t = t0 + k * NGW; if (t < T) {
                float* orow = args.out + (size_t)t * DM; const bf16* ya = YB + (size_t)pa[k] * DM; const bf16* yb = YB + (size_t)pb[k] * DM;
                f32x4 v[8]; v2u a[8], b[8];
#pragma unroll
                for (int j = 0; j < 8; ++j) { const int col = 4 * F.lane + 256 * j; v[j] = *(const f32x4*)(orow + col); a[j] = *(const v2u*)(ya + col); b[j] = *(const v2u*)(yb + col); }
#pragma unroll
                for (int j = 0; j < 8; ++j) { const int col = 4 * F.lane + 256 * j; f32x4 o = v[j];
                    o.x += wa[k] * bflo(a[j].x) + wb[k] * bflo(b[j].x); o.y += wa[k] * bfhi(a[j].x) + wb[k] * bfhi(b[j].x); o.z += wa[k] * bflo(a[j].y) + wb[k] * bflo(b[j].y); o.w += wa[k] * bfhi(a[j].y) + wb[k] * bfhi(b[j].y);
                    *(f32x4*)(orow + col) = o; } } }
        }
    }
#undef IN
#undef SEAM
}

extern "C" void kernel_launch(void* const* d_in, const int* in_sizes, int n_in, void* d_out, int out_size, void* d_ws, size_t ws_size, hipStream_t stream) {
    static int grid = 0;
    if (grid == 0) {
        if (n_in != 23 || in_sizes[0] != T * DM || out_size != T * DM || ws_size < WS_END) { fprintf(stderr, "kernel_launch: unexpected shapes (n_in %d, in0 %d, out %d, ws %zu)\n", n_in, n_in > 0 ? in_sizes[0] : -1, out_size, ws_size); grid = -1; return; }
        int dev = 0, cus = 0, per_cu = 0;
        if (hipGetDevice(&dev) != hipSuccess || hipDeviceGetAttribute(&cus, hipDeviceAttributeMultiprocessorCount, dev) != hipSuccess) { grid = -1; return; }
        if (hipFuncSetAttribute((const void*)fwd, hipFuncAttributeMaxDynamicSharedMemorySize, LDS_BYTES) != hipSuccess) { fprintf(stderr, "kernel_launch: hipFuncSetAttribute failed\n"); grid = -1; return; }
        if (hipOccupancyMaxActiveBlocksPerMultiprocessor(&per_cu, (const void*)fwd, NWAVES * 64, LDS_BYTES) != hipSuccess || per_cu < 1) fprintf(stderr, "kernel_launch: occupancy query reports %d\n", per_cu);
        (void)hipGetLastError();
        grid = cus < 256 ? cus : 256;
    }
    if (grid < 0) return;
    if (hipMemsetAsync((char*)d_ws + WS_CTL, 0, CTL_ZERO_BYTES, stream) != hipSuccess) return;
    Args a{};
    for (int i = 0; i < 23; ++i) a.in[i] = (const float*)d_in[i];
    a.out = (float*)d_out; a.ws = (unsigned char*)d_ws;
    for (int i = 0; i < 8; ++i) a.invf[i] = (float)pow(500000.0, -(double)(2 * i) / 16.0);
    constexpr int NL = MK_N_LAUNCHES;
    for (int li = 0; li < NL; ++li) {
        a.ph_lo = (NL == 1) ? 0 : li; a.ph_hi = (NL == 1) ? NPHASE : li + 1;
        hipLaunchKernelGGL(fwd, dim3(grid), dim3(NWAVES * 64), LDS_BYTES, stream, a);
        if (hipPeekAtLastError() != hipSuccess) { fprintf(stderr, "kernel_launch: launch %d failed\n", li); break; }
    }
}
```
